# Optimizing an MI355X kernel written in HIP

```python
import math
import jax
import jax.numpy as jnp
from jax import lax
import numpy as np


D_MODEL = 1024
BATCH = 16
SEQ = 2048
DEPTH = 4

CTX_LEN = 256
GRID_W = 64
HEAD_DIM = 64
ROPE_BASE = 10000.0
EPS = 1e-6
NEG_INF = -1e30

GDN_HEADS = D_MODEL // 128
GDN_DIM = 64
GDN_CHUNK = 64
SHORT_CONV = 3
DIFF_HEADS = D_MODEL // 256
DIFF_DIM = 64
DIFF_VDIM = 2 * DIFF_DIM
Q_BLOCK = 128
SWA_HEADS = D_MODEL // 128
SWA_KV_HEADS = 2
SWA_GROUP = SWA_HEADS // SWA_KV_HEADS
SWA_WINDOW = 128
SWA_BLOCK = 128
HY_CH = D_MODEL // 2
HY_ORDER = 2
HY_BANDS = 16
HY_EMB = 1 + 2 * HY_BANDS
HY_HID = 64
HY_MIN_DECAY = math.log(1e-2) / 1.5
HY_MAX_DECAY = math.log(1e-2) / 0.3
D_FF = ((8 * D_MODEL // 3 + 127) // 128) * 128
FFN_CONV = 3
N_MOD = 6

AB_SPLITS = (3 * GDN_HEADS * GDN_DIM, GDN_HEADS * GDN_DIM, 2 * GDN_HEADS, 2 * GDN_HEADS,
             DIFF_HEADS * 2 * DIFF_DIM, DIFF_HEADS * 2 * DIFF_DIM, DIFF_HEADS * DIFF_VDIM)
AB_OUT = GDN_HEADS * GDN_DIM + DIFF_HEADS * DIFF_VDIM
CD_SPLITS = (SWA_HEADS * HEAD_DIM, SWA_KV_HEADS * HEAD_DIM, SWA_KV_HEADS * HEAD_DIM, 3 * HY_CH)
CD_OUT = SWA_HEADS * HEAD_DIM + HY_CH

kernel_name = 'hybrid_dit_deltanet_diffattn_swa_hyena'


def rmsnorm(x, g):
    xf = x.astype(jnp.float32)
    y = xf * lax.rsqrt(jnp.mean(xf * xf, axis=-1, keepdims=True) + EPS)
    return (y * g.astype(jnp.float32)).astype(x.dtype)


def l2norm(x):
    return x * lax.rsqrt(jnp.sum(x * x, axis=-1, keepdims=True) + EPS)


def modulate(h, shift, scale):
    return h * (1.0 + scale) + shift


def split_cols(t, sizes):
    return jnp.split(t, np.cumsum(sizes)[:-1].tolist(), axis=-1)


def dwconv(x, w):
    k = w.shape[0]
    r = k // 2
    n = x.shape[1]
    xp = jnp.pad(x, ((0, 0), (r, r), (0, 0)))
    return sum(xp[:, i:i + n] * w[i] for i in range(k))


def axial_rope_angles(n_tokens):
    rows = n_tokens // GRID_W
    row = jnp.repeat(jnp.arange(rows, dtype=jnp.float32), GRID_W)
    col = jnp.tile(jnp.arange(GRID_W, dtype=jnp.float32), rows)
    half = HEAD_DIM // 2
    inv = ROPE_BASE ** (-jnp.arange(0, half, 2, dtype=jnp.float32) / half)
    return row[:, None] * inv, col[:, None] * inv


def rope_rotate(x, ang):
    cos = jnp.cos(ang)[:, None, :].astype(x.dtype)
    sin = jnp.sin(ang)[:, None, :].astype(x.dtype)
    x1, x2 = jnp.split(x, 2, axis=-1)
    return jnp.concatenate([x1 * cos - x2 * sin, x2 * cos + x1 * sin], axis=-1)


def rope2d(x, ang_row, ang_col):
    xr, xc = jnp.split(x, 2, axis=-1)
    return jnp.concatenate([rope_rotate(xr, ang_row), rope_rotate(xc, ang_col)], axis=-1)


def gated_delta_chunked(q, k, v, g, beta, s0):
    b, h, n, dk = q.shape
    dv = v.shape[-1]
    c = GDN_CHUNK
    nc = n // c
    f32 = jnp.float32
    q = q.astype(f32).reshape(b, h, nc, c, dk)
    k = k.astype(f32).reshape(b, h, nc, c, dk)
    v = v.astype(f32).reshape(b, h, nc, c, dv)
    g = g.astype(f32).reshape(b, h, nc, c)
    beta = beta.astype(f32).reshape(b, h, nc, c)
    gc = jnp.cumsum(g, axis=-1)
    pos = jnp.arange(c)
    incl = pos[:, None] >= pos[None, :]
    strict = pos[:, None] > pos[None, :]
    diff = gc[..., :, None] - gc[..., None, :]
    decay = jnp.where(incl, jnp.exp(jnp.where(incl, diff, 0.0)), 0.0)
    kb = k * beta[..., None]
    a = jnp.where(strict, jnp.einsum('bhnid,bhnjd->bhnij', kb, k) * decay, 0.0)
    rhs = jnp.concatenate([v * beta[..., None], kb * jnp.exp(gc)[..., None]], axis=-1)
    sol = lax.linalg.triangular_solve(a, rhs, left_side=True, lower=True, unit_diagonal=True)
    u, w = sol[..., :dv], sol[..., dv:]
    qk = jnp.where(incl, jnp.einsum('bhnid,bhnjd->bhnij', q, k) * decay, 0.0)
    g_last = gc[..., -1]
    q_dec = q * jnp.exp(gc)[..., None]
    k_tail = k * jnp.exp(g_last[..., None] - gc)[..., None]

    def step(s, xs):
        w_n, u_n, qk_n, q_n, k_n, gl_n = xs
        v_new = u_n - jnp.einsum('bhcd,bhde->bhce', w_n, s)
        o_n = jnp.einsum('bhcd,bhde->bhce', q_n, s) + jnp.einsum('bhij,bhje->bhie', qk_n, v_new)
        s = s * jnp.exp(gl_n)[..., None, None] + jnp.einsum('bhcd,bhce->bhde', k_n, v_new)
        return s, o_n

    xs = tuple(jnp.moveaxis(t, 2, 0) for t in (w, u, qk, q_dec, k_tail, g_last))
    s_final, o = lax.scan(step, s0.astype(f32), xs)
    return jnp.moveaxis(o, 0, 2).reshape(b, h, n, dv), s_final


def gdn_prep(p_qkv, p_beta, p_alpha, conv_w, a_log, dt_bias):
    b, n, _ = p_qkv.shape
    qkv = jax.nn.silu(dwconv(p_qkv, conv_w)).astype(jnp.float32)
    q, k, v = (t.reshape(b, n, GDN_HEADS, GDN_DIM).transpose(0, 2, 1, 3) for t in jnp.split(qkv, 3, axis=-1))
    q = l2norm(q) * GDN_DIM ** -0.5
    k = l2norm(k)
    to_dir = lambda t: t.astype(jnp.float32).reshape(b, n, 2, GDN_HEADS).transpose(2, 0, 3, 1)
    beta = jax.nn.sigmoid(to_dir(p_beta))
    g = -jnp.exp(a_log.astype(jnp.float32))[:, None, :, None] * jax.nn.softplus(
        to_dir(p_alpha) + dt_bias.astype(jnp.float32)[:, None, :, None])
    return q, k, v, g, beta


def gdn_bidir(q, k, v, g, beta, s0):
    flip = lambda t: jnp.flip(t, axis=2)
    o_f, s_f = gated_delta_chunked(q, k, v, g[0], beta[0], s0[0])
    o_b, s_b = gated_delta_chunked(flip(q), flip(k), flip(v), flip(g[1]), flip(beta[1]), s0[1])
    return o_f + flip(o_b), jnp.stack([s_f, s_b])


def gdn_out(o, gate, norm_g):
    b, h, n, d = o.shape
    o = rmsnorm(o.transpose(0, 2, 1, 3).astype(gate.dtype), norm_g)
    return (o * jax.nn.silu(gate.reshape(b, n, h, d))).reshape(b, n, h * d)


def diff_lambda_value(lam_p, lam_init):
    lp = lam_p.astype(jnp.float32)
    return jnp.exp(jnp.sum(lp[0] * lp[1])) - jnp.exp(jnp.sum(lp[2] * lp[3])) + lam_init


def diff_attention(q, k, v, lam):
    s = jnp.einsum('bqhtd,bmhtd->bhtqm', q, k).astype(jnp.float32) * DIFF_DIM ** -0.5
    p = jax.nn.softmax(s, axis=-1)
    a = p[:, :, 0] - lam * p[:, :, 1]
    return jnp.einsum('bhqm,bmhe->bqhe', a.astype(v.dtype), v)


def diff_attention_blocks(q, k, v, lam):
    b, n = q.shape[:2]
    qb = jnp.moveaxis(q.reshape(b, n // Q_BLOCK, Q_BLOCK, *q.shape[2:]), 1, 0)
    o = lax.map(lambda t: diff_attention(t, k, v, lam), qb)
    return jnp.moveaxis(o, 0, 1).reshape(b, n, *o.shape[3:])


def diff_out(o, norm_g, lam_init):
    b, n, h, d = o.shape
    return (rmsnorm(o, norm_g) * (1.0 - lam_init)).reshape(b, n, h * d)


def rope_pairs(t, rope):
    b, n, h, two, d = t.shape
    return rope2d(t.reshape(b, n, h * two, d), *rope).reshape(b, n, h, two, d)


def sink_probs(s, sink):
    col = jnp.broadcast_to(sink.astype(jnp.float32).reshape(SWA_KV_HEADS, SWA_GROUP, 1, 1), s.shape[:-1] + (1,))
    return jax.nn.softmax(jnp.concatenate([col, s], axis=-1), axis=-1)[..., 1:]


def swa_context(q, k, v, sink):
    b, n = q.shape[:2]
    qg = q.reshape(b, n, SWA_KV_HEADS, SWA_GROUP, HEAD_DIM)
    s = jnp.einsum('bqkgd,bmkd->bkgqm', qg, k).astype(jnp.float32) * HEAD_DIM ** -0.5
    p = sink_probs(s, sink)
    return jnp.einsum('bkgqm,bmkd->bqkgd', p.astype(v.dtype), v).reshape(b, n, SWA_HEADS * HEAD_DIM)


def swa_latent(q, k, v, kc, vc, sink):
    b, n = q.shape[:2]
    nb = n // SWA_BLOCK
    qb = jnp.moveaxis(q.reshape(b, nb, SWA_BLOCK, SWA_KV_HEADS, SWA_GROUP, HEAD_DIM), 1, 0)
    pad = ((0, 0), (SWA_BLOCK, SWA_BLOCK), (0, 0), (0, 0))
    kp, vp = jnp.pad(k, pad), jnp.pad(v, pad)
    span = 3 * SWA_BLOCK
    qi = jnp.arange(SWA_BLOCK)[:, None]
    m = jnp.arange(span)[None, :]
    in_window = jnp.abs(qi + SWA_BLOCK - m) <= SWA_WINDOW
    ctx_ok = jnp.ones((SWA_BLOCK, kc.shape[1]), bool)

    def block(args):
        i, qblk = args
        start = i * SWA_BLOCK
        kw = jnp.concatenate([lax.dynamic_slice_in_dim(kp, start, span, axis=1), kc], axis=1)
        vw = jnp.concatenate([lax.dynamic_slice_in_dim(vp, start, span, axis=1), vc], axis=1)
        j = start - SWA_BLOCK + m
        valid = jnp.concatenate([in_window & (j >= 0) & (j < n), ctx_ok], axis=1)
        s = jnp.einsum('bqkgd,bmkd->bkgqm', qblk, kw).astype(jnp.float32) * HEAD_DIM ** -0.5
        p = sink_probs(jnp.where(valid, s, NEG_INF), sink)
        return jnp.einsum('bkgqm,bmkd->bqkgd', p.astype(vw.dtype), vw)

    o = lax.map(block, (jnp.arange(nb), qb))
    return jnp.moveaxis(o, 0, 1).reshape(b, n, SWA_HEADS * HEAD_DIM)


def hyena_filters(n, w1, b1, w2, b2, w3, freq):
    f32 = jnp.float32
    pos = jnp.arange(n, dtype=f32)
    t = pos / max(n - 1, 1)
    ang = (2.0 * math.pi * pos / n)[:, None] * jnp.linspace(1e-4, HY_BANDS - 1, HY_BANDS, dtype=f32)[None, :]
    feats = jnp.concatenate([t[:, None], jnp.cos(ang), -jnp.sin(ang)], axis=-1)
    h = jnp.sin(freq[0].astype(f32) * (feats @ w1.astype(f32) + b1.astype(f32)))
    h = jnp.sin(freq[1].astype(f32) * (h @ w2.astype(f32) + b2.astype(f32)))
    h = (h @ w3.astype(f32)).reshape(n, HY_ORDER, 2, HY_CH)
    deltas = jnp.abs(jnp.linspace(HY_MIN_DECAY, HY_MAX_DECAY, HY_CH, dtype=f32))
    h = h * jnp.exp(-t[:, None, None, None] * deltas)
    kern = jnp.concatenate([h[:, :, 0], jnp.zeros((1, HY_ORDER, HY_CH), f32), jnp.flip(h[1:, :, 1], axis=0)], axis=0)
    kern = kern * lax.rsqrt(jnp.sum(kern * kern, axis=0, keepdims=True) + EPS)
    return jnp.fft.rfft(kern, axis=0)


def fft_long_conv(z, kf):
    n = z.shape[1]
    zf = jnp.fft.rfft(z.astype(jnp.float32), n=2 * n, axis=1)
    return jnp.fft.irfft(zf * kf[None], n=2 * n, axis=1)[:, :n].astype(z.dtype)


def hyena(u, conv_w, kf, bias):
    v, x1, x2 = jnp.split(dwconv(u, conv_w), 3, axis=-1)
    z = v
    for o, gate in enumerate((x1, x2)):
        z = gate * (fft_long_conv(z, kf[:, o]) + z * bias[o])
    return z


def mixer_ab(hx, hz, w_in, w_out, conv_w, a_log, dt_bias, gdn_g, lam_p, diff_g, lam_init, rope, with_ctx_out):
    b, n, _ = hx.shape
    nc = hz.shape[1]
    px = split_cols(hx @ w_in, AB_SPLITS)
    pz = split_cols(hz @ w_in, AB_SPLITS)
    qz, kz, vz, gz, bz = gdn_prep(pz[0], pz[2], pz[3], conv_w, a_log, dt_bias)
    qx, kx, vx, gx, bx = gdn_prep(px[0], px[2], px[3], conv_w, a_log, dt_bias)
    s0 = jnp.zeros((2, b, GDN_HEADS, GDN_DIM, GDN_DIM), jnp.float32)
    oaz, s_ctx = gdn_bidir(qz, kz, vz, gz, bz, s0)
    oax, _ = gdn_bidir(qx, kx, vx, gx, bx, s_ctx)
    lam = diff_lambda_value(lam_p, lam_init)
    dq_x = rope_pairs(px[4].reshape(b, n, DIFF_HEADS, 2, DIFF_DIM), rope)
    dk_x = rope_pairs(px[5].reshape(b, n, DIFF_HEADS, 2, DIFF_DIM), rope)
    dv_x = px[6].reshape(b, n, DIFF_HEADS, DIFF_VDIM)
    dk_z = pz[5].reshape(b, nc, DIFF_HEADS, 2, DIFF_DIM)
    dv_z = pz[6].reshape(b, nc, DIFF_HEADS, DIFF_VDIM)
    obx = diff_attention_blocks(dq_x, jnp.concatenate([dk_x, dk_z], axis=1), jnp.concatenate([dv_x, dv_z], axis=1), lam)
    out_x = jnp.concatenate([gdn_out(oax, px[1], gdn_g), diff_out(obx, diff_g, lam_init)], axis=-1) @ w_out
    if not with_ctx_out:
        return out_x, None
    dq_z = pz[4].reshape(b, nc, DIFF_HEADS, 2, DIFF_DIM)
    obz = diff_attention(dq_z, dk_z, dv_z, lam)
    out_z = jnp.concatenate([gdn_out(oaz, pz[1], gdn_g), diff_out(obz, diff_g, lam_init)], axis=-1) @ w_out
    return out_x, out_z


def mixer_cd(hx, hz, w_in, w_out, sink, hy_conv, hy_w1, hy_b1, hy_w2, hy_b2, hy_w3, hy_freq, hy_bias, rope, with_ctx_out):
    b, n, _ = hx.shape
    nc = hz.shape[1]
    qx, kx, vx, ux = split_cols(hx @ w_in, CD_SPLITS)
    qx = rope2d(qx.reshape(b, n, SWA_HEADS, HEAD_DIM), *rope)
    kx = rope2d(kx.reshape(b, n, SWA_KV_HEADS, HEAD_DIM), *rope)
    vx = vx.reshape(b, n, SWA_KV_HEADS, HEAD_DIM)
    if with_ctx_out:
        qz, kz, vz, uz = split_cols(hz @ w_in, CD_SPLITS)
    else:
        kv_lo = CD_SPLITS[0]
        kz, vz = split_cols(hz @ w_in[:, kv_lo:kv_lo + CD_SPLITS[1] + CD_SPLITS[2]], CD_SPLITS[1:3])
    kz = kz.reshape(b, nc, SWA_KV_HEADS, HEAD_DIM)
    vz = vz.reshape(b, nc, SWA_KV_HEADS, HEAD_DIM)
    ocx = swa_latent(qx, kx, vx, kz, vz, sink)
    odx = hyena(ux, hy_conv, hyena_filters(n, hy_w1, hy_b1, hy_w2, hy_b2, hy_w3, hy_freq), hy_bias)
    out_x = jnp.concatenate([ocx, odx], axis=-1) @ w_out
    if not with_ctx_out:
        return out_x, None
    ocz = swa_context(qz.reshape(b, nc, SWA_HEADS, HEAD_DIM), kz, vz, sink)
    odz = hyena(uz, hy_conv, hyena_filters(nc, hy_w1, hy_b1, hy_w2, hy_b2, hy_w3, hy_freq), hy_bias)
    out_z = jnp.concatenate([ocz, odz], axis=-1) @ w_out
    return out_x, out_z


def conv_ffn(h, w_up, conv_w, w_down):
    a, g = jnp.split(dwconv(h @ w_up, conv_w), 2, axis=-1)
    return (jax.nn.silu(g) * a) @ w_down


def setup_inputs(seed: int = 0) -> dict:
    key = jax.random.key(seed)
    ks = iter(jax.random.split(key, 40))
    f32 = jnp.float32
    nrm = lambda shape, scale: jax.random.normal(next(ks), shape, f32) * scale
    n_even, n_odd = (DEPTH + 1) // 2, DEPTH // 2
    d = D_MODEL
    p_ab, p_cd = sum(AB_SPLITS), sum(CD_SPLITS)
    dt = jnp.exp(jax.random.uniform(next(ks), (n_even, 2, GDN_HEADS), f32, minval=math.log(1e-3), maxval=math.log(1e-1)))
    return {
        'x': nrm((BATCH, SEQ, d), 1.0),
        'c': nrm((BATCH, d), 1.0),
        'ctx': nrm((BATCH, CTX_LEN, d), 1.0),
        'c_ctx': nrm((d,), 1.0),
        'w_mod': nrm((DEPTH, d, N_MOD * d), 0.5 * d ** -0.5),
        'b_mod': nrm((DEPTH, N_MOD * d), 0.02),
        'norm_g': 1.0 + nrm((DEPTH, 4, d), 0.02),
        'ffn_w_up': nrm((DEPTH, d, 2 * D_FF), d ** -0.5),
        'ffn_conv': nrm((DEPTH, FFN_CONV, 2 * D_FF), FFN_CONV ** -0.5),
        'ffn_w_down': nrm((DEPTH, D_FF, d), D_FF ** -0.5),
        'ab_w_in': nrm((n_even, d, p_ab), d ** -0.5),
        'ab_w_out': nrm((n_even, AB_OUT, d), AB_OUT ** -0.5),
        'gdn_conv': nrm((n_even, SHORT_CONV, 3 * GDN_HEADS * GDN_DIM), SHORT_CONV ** -0.5),
        'gdn_a_log': jnp.log(jax.random.uniform(next(ks), (n_even, 2, GDN_HEADS), f32, minval=1.0, maxval=16.0)),
        'gdn_dt_bias': dt + jnp.log(-jnp.expm1(-dt)),
        'gdn_norm_g': 1.0 + nrm((n_even, GDN_DIM), 0.02),
        'diff_lambda': nrm((n_even, 4, DIFF_DIM), 0.1),
        'diff_norm_g': 1.0 + nrm((n_even, DIFF_VDIM), 0.02),
        'cd_w_in': nrm((n_odd, d, p_cd), d ** -0.5),
        'cd_w_out': nrm((n_odd, CD_OUT, d), CD_OUT ** -0.5),
        'swa_sink': nrm((n_odd, SWA_HEADS), 1.0),
        'hy_conv': nrm((n_odd, SHORT_CONV, 3 * HY_CH), SHORT_CONV ** -0.5),
        'hy_w1': nrm((n_odd, HY_EMB, HY_HID), HY_EMB ** -0.5),
        'hy_b1': nrm((n_odd, HY_HID), 0.1),
        'hy_w2': nrm((n_odd, HY_HID, HY_HID), HY_HID ** -0.5),
        'hy_b2': nrm((n_odd, HY_HID), 0.1),
        'hy_w3': nrm((n_odd, HY_HID, HY_ORDER * 2 * HY_CH), HY_HID ** -0.5),
        'hy_freq': 1.0 + nrm((n_odd, 2, HY_HID), 0.1),
        'hy_bias': nrm((n_odd, HY_ORDER, HY_CH), 1.0),
    }


def reference(x, c, ctx, c_ctx, w_mod, b_mod, norm_g, ffn_w_up, ffn_conv, ffn_w_down,
              ab_w_in, ab_w_out, gdn_conv, gdn_a_log, gdn_dt_bias, gdn_norm_g, diff_lambda, diff_norm_g,
              cd_w_in, cd_w_out, swa_sink, hy_conv, hy_w1, hy_b1, hy_w2, hy_b2, hy_w3, hy_freq, hy_bias):
    b, n, d = x.shape
    rope = axial_rope_angles(n)
    z = ctx
    sc, scc = jax.nn.silu(c), jax.nn.silu(c_ctx)
    for l in range(DEPTH):
        last = l == DEPTH - 1
        i = l // 2
        mx = (sc @ w_mod[l] + b_mod[l]).reshape(b, 1, N_MOD, d)
        mz = (scc @ w_mod[l] + b_mod[l]).reshape(1, 1, N_MOD, d)
        hx = modulate(rmsnorm(x, norm_g[l, 0]), mx[:, :, 0], mx[:, :, 1])
        hz = modulate(rmsnorm(z, norm_g[l, 0]), mz[:, :, 0], mz[:, :, 1])
        if l % 2 == 0:
            lam_init = 0.8 - 0.6 * math.exp(-0.3 * l)
            ox, oz = mixer_ab(hx, hz, ab_w_in[i], ab_w_out[i], gdn_conv[i], gdn_a_log[i], gdn_dt_bias[i], gdn_norm_g[i],
                              diff_lambda[i], diff_norm_g[i], lam_init, rope, not last)
        else:
            ox, oz = mixer_cd(hx, hz, cd_w_in[i], cd_w_out[i], swa_sink[i], hy_conv[i], hy_w1[i], hy_b1[i], hy_w2[i],
                              hy_b2[i], hy_w3[i], hy_freq[i], hy_bias[i], rope, not last)
        x = x + mx[:, :, 2] * rmsnorm(ox, norm_g[l, 1])
        hx = modulate(rmsnorm(x, norm_g[l, 2]), mx[:, :, 3], mx[:, :, 4])
        x = x + mx[:, :, 5] * rmsnorm(conv_ffn(hx, ffn_w_up[l], ffn_conv[l], ffn_w_down[l]), norm_g[l, 3])
        if not last:
            z = z + mz[:, :, 2] * rmsnorm(oz, norm_g[l, 1])
            hz = modulate(rmsnorm(z, norm_g[l, 2]), mz[:, :, 3], mz[:, :, 4])
            z = z + mz[:, :, 5] * rmsnorm(conv_ffn(hz, ffn_w_up[l], ffn_conv[l], ffn_w_down[l]), norm_g[l, 3])
    return x
```

```cpp
#include <hip/hip_runtime.h>
#include <hip/hip_cooperative_groups.h>
#include <cstdio>
#include <cstdint>
namespace cg = cooperative_groups;

typedef __attribute__((ext_vector_type(8))) short bf16x8;
typedef __attribute__((ext_vector_type(4))) float f32x4;
typedef unsigned short u16;
typedef unsigned u32x4 __attribute__((ext_vector_type(4)));
typedef unsigned u32x2 __attribute__((ext_vector_type(2)));
__device__ __forceinline__ u32x4 mk4(unsigned a, unsigned b, unsigned c, unsigned d) { u32x4 v; v.x = a; v.y = b; v.z = c; v.w = d; return v; }

#ifndef PREP
#define PREP 1
#endif
#ifndef MULTI_LAUNCH
#define MULTI_LAUNCH 0
#endif

constexpr int D = 1024, NB = 16, SEQ = 2048, CTX = 256, TX = NB * SEQ, TZ = NB * CTX, TT = TX + TZ;
constexpr int PAB = 3616, PCD = 2304, DFF = 2816, NKEY = SEQ + CTX;
constexpr float EPS = 1e-6f;
constexpr int LDS_BYTES = 73728;

constexpr size_t al(size_t x) { return (x + 255) & ~(size_t)255; }
constexpr size_t OFF_CNT = 0;
constexpr size_t OFF_LAM = 4096;
constexpr size_t OFF_ROPE = 8192;
constexpr size_t OFF_MODS = OFF_ROPE + 2048 * 32 * 8;
constexpr size_t OFF_H2 = OFF_MODS + (size_t)4 * 17 * 6144 * 4;
constexpr size_t OFF_RN = OFF_H2 + (size_t)(2048 + 2048 + 256) * 64 * 4;
constexpr int FLX = 2 * SEQ + 16, FLZ = 2 * CTX + 16;
constexpr size_t OFF_FX = OFF_RN + 2 * 2 * 512 * 4;
constexpr size_t OFF_FZ = al(OFF_FX + (size_t)2 * 512 * FLX * 2);
constexpr size_t OFF_Z = al(OFF_FZ + (size_t)2 * 512 * FLZ * 2);
constexpr size_t OFF_HA = OFF_Z + (size_t)TZ * D * 4;
constexpr size_t OFF_O = OFF_HA + (size_t)TT * D * 2;
constexpr size_t OFF_WIN = OFF_O + (size_t)TT * D * 2;
constexpr size_t OFF_WOUT = OFF_WIN + (size_t)PAB * D * 2;
constexpr size_t OFF_WUP = OFF_WOUT + (size_t)D * D * 2;
constexpr size_t OFF_WDN = OFF_WUP + (size_t)2 * DFF * D * 2;
constexpr size_t OFF_BIG = OFF_WDN + (size_t)D * DFF * 2;
constexpr size_t OFF_VTD = OFF_BIG + (size_t)TT * PAB * 2;
constexpr size_t OFF_UT = OFF_BIG + (size_t)TT * PCD * 2;
constexpr size_t OFF_VTS = OFF_UT + (size_t)1536 * TT * 2;
constexpr size_t OFF_ACT = OFF_BIG;
constexpr size_t OFF_U = OFF_BIG + (size_t)TT * DFF * 2;
constexpr size_t WS_END = OFF_VTD + (size_t)16 * 4 * 128 * NKEY * 2;
static_assert(OFF_VTS + (size_t)16 * 2 * 64 * NKEY * 2 <= WS_END, "ws");
static_assert(OFF_U + (size_t)8192 * 2 * DFF * 2 <= WS_END, "ws");
constexpr size_t OFF_XBAR = (WS_END + 255) & ~(size_t)255;
static_assert(OFF_XBAR + 16384 <= (size_t)512 * 1024 * 1024, "ws");

struct Params {
  const float *x, *c, *ctx, *c_ctx, *w_mod, *b_mod, *norm_g, *ffn_w_up, *ffn_conv, *ffn_w_down, *ab_w_in, *ab_w_out,
      *gdn_conv, *gdn_a_log, *gdn_dt_bias, *gdn_norm_g, *diff_lambda, *diff_norm_g, *cd_w_in, *cd_w_out, *swa_sink,
      *hy_conv, *hy_w1, *hy_b1, *hy_w2, *hy_b2, *hy_w3, *hy_freq, *hy_bias;
  float* out;
  char* ws;
  int ph_lo, ph_hi;
};

__device__ __forceinline__ int otid() { int t = threadIdx.x; asm volatile("" : "+v"(t)); return t; }
#define MFMA(a, b, c) __builtin_amdgcn_mfma_f32_16x16x32_bf16(a, b, c, 0, 0, 0)

typedef float f32x2_t __attribute__((ext_vector_type(2)));
typedef __bf16 bf16x2_t __attribute__((ext_vector_type(2)));
__device__ __forceinline__ u16 f2bf(float f) { __bf16 r = (__bf16)f; return __builtin_bit_cast(u16, r); }
__device__ __forceinline__ float bf2f(u16 h) { return __uint_as_float(((unsigned)h) << 16); }
__device__ __forceinline__ unsigned pack2(float a, float b) { f32x2_t v = {a, b}; bf16x2_t r = __builtin_convertvector(v, bf16x2_t); return __builtin_bit_cast(unsigned, r); }
__device__ __forceinline__ float lo2f(unsigned u) { return __uint_as_float(u << 16); }
__device__ __forceinline__ float hi2f(unsigned u) { return __uint_as_float(u & 0xffff0000u); }
__device__ __forceinline__ void unpack8(const u32x4& v, float* f) {
  f[0] = lo2f(v.x); f[1] = hi2f(v.x); f[2] = lo2f(v.y); f[3] = hi2f(v.y);
  f[4] = lo2f(v.z); f[5] = hi2f(v.z); f[6] = lo2f(v.w); f[7] = hi2f(v.w);
}
__device__ __forceinline__ u32x4 pack8(const float* f) {
  return mk4(pack2(f[0], f[1]), pack2(f[2], f[3]), pack2(f[4], f[5]), pack2(f[6], f[7]));
}
__device__ __forceinline__ bf16x8 as_bf8(const u32x4& v) {
  return __builtin_bit_cast(bf16x8, v);
}
__device__ __forceinline__ float siluf(float v) { return v / (1.f + expf(-v)); }
__device__ __forceinline__ float silu_fast(float v) { return v * __builtin_amdgcn_rcpf(1.f + __builtin_amdgcn_exp2f(-1.4426950408889634f * v)); }
__device__ __forceinline__ float wave_sum(float v) {
#pragma unroll
  for (int o = 32; o > 0; o >>= 1) v += __shfl_xor(v, o);
  return v;
}

__device__ __forceinline__ void gemm_tile(const u16* __restrict__ A, int lda, const u16* __restrict__ Bt, int ldb, u16* __restrict__ C,
                          int ldc, int m0, int n0, int N, int K, char* smem) {
  const int tid = otid(), lane = tid & 63, wid = tid >> 6, wr = wid >> 1, wc = wid & 1, l15 = lane & 15, quad = lane >> 4;
  u16* As = (u16*)smem;
  u16* Bs = As + 128 * 72;
  f32x4 acc[4][4];
#pragma unroll
  for (int i = 0; i < 4; ++i)
#pragma unroll
    for (int j = 0; j < 4; ++j) acc[i][j] = f32x4{0.f, 0.f, 0.f, 0.f};
  u32x4 ra[4], rb[4];
  const u16* ap[4];
  const u16* bp[4];
#pragma unroll
  for (int i = 0; i < 4; ++i) {
    int idx = tid + 256 * i, row = idx >> 3, c8 = idx & 7;
    ap[i] = A + (size_t)(m0 + row) * lda + c8 * 8;
    int bn = n0 + row; if (bn > N - 1) bn = N - 1;
    bp[i] = Bt + (size_t)bn * ldb + c8 * 8;
  }
#pragma unroll
  for (int i = 0; i < 4; ++i) { ra[i] = *(const u32x4*)(ap[i]); rb[i] = *(const u32x4*)(bp[i]); }
#define GEMM_STEP(RA, RB, KK) do { \
    __syncthreads(); \
    _Pragma("unroll") for (int i = 0; i < 4; ++i) { \
      int idx = tid + 256 * i, row = idx >> 3, c8 = idx & 7; \
      *(u32x4*)(As + row * 72 + c8 * 8) = RA[i]; \
      *(u32x4*)(Bs + row * 72 + c8 * 8) = RB[i]; \
    } \
    __syncthreads(); \
    if ((KK) + 64 < K) { \
      _Pragma("unroll") for (int i = 0; i < 4; ++i) { RA[i] = *(const u32x4*)(ap[i] + (KK) + 64); RB[i] = *(const u32x4*)(bp[i] + (KK) + 64); } \
    } \
    _Pragma("unroll") for (int ks = 0; ks < 2; ++ks) { \
      bf16x8 af[4], bfr[4]; \
      _Pragma("unroll") for (int mt = 0; mt < 4; ++mt) af[mt] = *(const bf16x8*)(As + (wr * 64 + mt * 16 + l15) * 72 + ks * 32 + quad * 8); \
      _Pragma("unroll") for (int n4 = 0; n4 < 4; ++n4) bfr[n4] = *(const bf16x8*)(Bs + (wc * 64 + n4 * 16 + l15) * 72 + ks * 32 + quad * 8); \
      _Pragma("unroll") for (int mt = 0; mt < 4; ++mt) \
        _Pragma("unroll") for (int n4 = 0; n4 < 4; ++n4) acc[mt][n4] = MFMA(af[mt], bfr[n4], acc[mt][n4]); \
    } \
  } while (0)
  for (int k0 = 0; k0 < K; k0 += 64) {
    GEMM_STEP(ra, rb, k0);
  }
#undef GEMM_STEP
#pragma unroll
  for (int mt = 0; mt < 4; ++mt)
#pragma unroll
    for (int nt = 0; nt < 4; ++nt) {
      int col = n0 + wc * 64 + nt * 16 + l15;
      if (col < N) {
#pragma unroll
        for (int j = 0; j < 4; ++j) {
          int row = m0 + wr * 64 + mt * 16 + quad * 4 + j;
          C[(size_t)row * ldc + col] = f2bf(acc[mt][nt][j]);
        }
      }
    }
}

__device__ __forceinline__ void gemm_tile256(const u16* __restrict__ A, int lda, const u16* __restrict__ Bt, int ldb, u16* __restrict__ C,
                                             int ldc, int m0, int n0, int N, int K, char* smem) {
  const int tid = otid(), lane = tid & 63, wid = tid >> 6, wr = wid >> 1, wc = wid & 1, l15 = lane & 15, quad = lane >> 4;
  char* As = smem;
  char* Bs = smem + 32768;
  f32x4 acc[8][4];
#pragma unroll
  for (int i = 0; i < 8; ++i)
#pragma unroll
    for (int j = 0; j < 4; ++j) acc[i][j] = f32x4{0.f, 0.f, 0.f, 0.f};
  const u16* Ab = A + (size_t)m0 * lda;
  const u16* Bb = Bt + (size_t)n0 * ldb;
  const int srow = tid >> 3, sslot = tid & 7;
  const unsigned aoff = (unsigned)srow * lda + sslot * 8;
  const unsigned boff0 = (unsigned)srow * ldb + sslot * 8;
  const int wsw = srow * 128 + ((sslot ^ ((srow >> 1) & 7)) << 4);
  const int sw = l15 >> 1;
  const int ro0 = ((quad ^ sw) << 4), ro1 = (((4 + quad) ^ sw) << 4);
  const char* ard = As + (wr * 128 + l15) * 128;
  const char* brd = Bs + (wc * 64 + l15) * 128;
  u32x4 ra[8], rb[4];
#pragma unroll
  for (int i = 0; i < 8; ++i) ra[i] = *(const u32x4*)(Ab + (size_t)i * 32 * lda + aoff);
#pragma unroll
  for (int i = 0; i < 4; ++i) rb[i] = *(const u32x4*)(Bb + (size_t)i * 32 * ldb + boff0);
  for (int k0 = 0; k0 < K; k0 += 64) {
    __syncthreads();
#pragma unroll
    for (int i = 0; i < 8; ++i) *(u32x4*)(As + wsw + i * 4096) = ra[i];
#pragma unroll
    for (int i = 0; i < 4; ++i) *(u32x4*)(Bs + wsw + i * 4096) = rb[i];
    __syncthreads();
    if (k0 + 64 < K) {
#pragma unroll
      for (int i = 0; i < 8; ++i) ra[i] = *(const u32x4*)(Ab + (size_t)i * 32 * lda + aoff + k0 + 64);
    }
    __builtin_amdgcn_s_setprio(1);
    {
      bf16x8 b0[4], b1[4], afp[3];
#pragma unroll
      for (int n4 = 0; n4 < 4; ++n4) b0[n4] = *(const bf16x8*)(brd + n4 * 2048 + ro0);
#pragma unroll
      for (int g = 0; g < 3; ++g) afp[g] = *(const bf16x8*)(ard + g * 2048 + ro0);
      __builtin_amdgcn_sched_barrier(0);
#pragma unroll
      for (int g = 0; g < 16; ++g) {
#pragma unroll
        for (int n4 = 0; n4 < 4; ++n4) acc[g & 7][n4] = MFMA(afp[g % 3], (g < 8 ? b0[n4] : b1[n4]), acc[g & 7][n4]);
        if (g + 3 < 16) afp[g % 3] = *(const bf16x8*)(ard + ((g + 3) & 7) * 2048 + ((g + 3) < 8 ? ro0 : ro1));
        if (g >= 2 && g < 6) b1[g - 2] = *(const bf16x8*)(brd + (g - 2) * 2048 + ro1);
        if (g == 8 && k0 + 64 < K) {
#pragma unroll
          for (int i = 0; i < 4; ++i) rb[i] = *(const u32x4*)(Bb + (size_t)i * 32 * ldb + boff0 + k0 + 64);
        }
        __builtin_amdgcn_sched_barrier(0);
      }
    }
    __builtin_amdgcn_s_setprio(0);
  }
#pragma unroll
  for (int mt = 0; mt < 8; ++mt)
#pragma unroll
    for (int n4 = 0; n4 < 4; ++n4) {
      int col = n0 + wc * 64 + n4 * 16 + l15;
      if (col < N) {
#pragma unroll
        for (int j = 0; j < 4; ++j) {
          int row = m0 + wr * 128 + mt * 16 + quad * 4 + j;
          C[(size_t)row * ldc + col] = f2bf(acc[mt][n4][j]);
        }
      }
    }
}

#ifndef GEMM_REP
#define GEMM_REP 1
#endif
__device__ __forceinline__ void gemm_phase(const u16* A, int lda, const u16* Bt, int ldb, u16* C, int ldc, int M, int N, int K, char* smem) {
  const int MT = M / 256, NT = (N + 127) / 128, total = MT * NT;
  const int G = gridDim.x;
  const int full = (total / G) * G;
  const int ntask = full + 2 * (total - full);
#pragma unroll 1
  for (int rep = 0; rep < GEMM_REP; ++rep)
  for (int t = blockIdx.x; t < ntask; t += G) {
    const int tile = t < full ? t : full + ((t - full) >> 1);
    int g = tile / (16 * NT), rem = tile % (16 * NT);
    int mt = g * 16 + (rem & 15), nt = rem >> 4;
    if (t < full) gemm_tile256(A, lda, Bt, ldb, C, ldc, mt * 256, nt * 128, N, K, smem);
    else gemm_tile(A, lda, Bt, ldb, C, ldc, mt * 256 + ((t - full) & 1) * 128, nt * 128, N, K, smem);
  }
}

__device__ __forceinline__ void ffn_up_tile(const Params& p, int l, int rt, int nt, char* smem) {
  const int tid = otid(), lane = tid & 63, wid = tid >> 6, wr = wid >> 1, wc = wid & 1, l15 = lane & 15, quad = lane >> 4;
  const u16* A = (const u16*)(p.ws + OFF_HA);
  const u16* Bt = (const u16*)(p.ws + OFF_WUP);
  u16* act = (u16*)(p.ws + OFF_ACT);
  int seqbase, len, p0;
  if (rt < 272) { int sq = rt / 17; seqbase = sq * SEQ; len = SEQ; p0 = (rt - sq * 17) * 126; }
  else { int q = rt - 272, sq = q / 3; seqbase = TX + sq * CTX; len = CTX; p0 = (q - sq * 3) * 126; }
  u16* As = (u16*)smem;
  u16* Bs = As + 128 * 72;
  f32x4 acc[4][4];
#pragma unroll
  for (int i = 0; i < 4; ++i)
#pragma unroll
    for (int j = 0; j < 4; ++j) acc[i][j] = f32x4{0.f, 0.f, 0.f, 0.f};
  u32x4 ra[4], rb[4];
  const u16* ap[4];
  const u16* bp[4];
#pragma unroll
  for (int i = 0; i < 4; ++i) {
    int idx = tid + 256 * i, row = idx >> 3, c8 = idx & 7;
    int pos = p0 - 1 + row;
    pos = pos < 0 ? 0 : (pos > len - 1 ? len - 1 : pos);
    ap[i] = A + (size_t)(seqbase + pos) * D + c8 * 8;
    bp[i] = Bt + (size_t)(nt * 128 + row) * D + c8 * 8;
  }
  u32x4 ra2[4], rb2[4];
#pragma unroll
  for (int i = 0; i < 4; ++i) { ra[i] = *(const u32x4*)(ap[i]); rb[i] = *(const u32x4*)(bp[i]); }
#pragma unroll
  for (int i = 0; i < 4; ++i) { ra2[i] = *(const u32x4*)(ap[i] + 64); rb2[i] = *(const u32x4*)(bp[i] + 64); }
#define GEMM_STEP(RA, RB, KK) do { \
    __syncthreads(); \
    _Pragma("unroll") for (int i = 0; i < 4; ++i) { \
      int idx = tid + 256 * i, row = idx >> 3, c8 = idx & 7; \
      *(u32x4*)(As + row * 72 + c8 * 8) = RA[i]; \
      *(u32x4*)(Bs + row * 72 + c8 * 8) = RB[i]; \
    } \
    __syncthreads(); \
    if ((KK) + 128 < D) { \
      _Pragma("unroll") for (int i = 0; i < 4; ++i) { RA[i] = *(const u32x4*)(ap[i] + (KK) + 128); RB[i] = *(const u32x4*)(bp[i] + (KK) + 128); } \
    } \
    _Pragma("unroll") for (int ks = 0; ks < 2; ++ks) { \
      bf16x8 af[4], bfr[4]; \
      _Pragma("unroll") for (int mt = 0; mt < 4; ++mt) af[mt] = *(const bf16x8*)(As + (wr * 64 + mt * 16 + l15) * 72 + ks * 32 + quad * 8); \
      _Pragma("unroll") for (int n4 = 0; n4 < 4; ++n4) bfr[n4] = *(const bf16x8*)(Bs + (wc * 64 + n4 * 16 + l15) * 72 + ks * 32 + quad * 8); \
      _Pragma("unroll") for (int mt = 0; mt < 4; ++mt) \
        _Pragma("unroll") for (int n4 = 0; n4 < 4; ++n4) acc[mt][n4] = MFMA(af[mt], bfr[n4], acc[mt][n4]); \
    } \
  } while (0)
  for (int k0 = 0; k0 < D; k0 += 128) {
    GEMM_STEP(ra, rb, k0);
    GEMM_STEP(ra2, rb2, k0 + 64);
  }
#undef GEMM_STEP
  __syncthreads();
  u16* Us = (u16*)smem;
#pragma unroll
  for (int mt = 0; mt < 4; ++mt)
#pragma unroll
    for (int j = 0; j < 4; ++j) {
      const int row = wr * 64 + mt * 16 + quad * 4 + j;
      const int pos = p0 - 1 + row;
      const bool ok = pos >= 0 && pos < len;
#pragma unroll
      for (int n4 = 0; n4 < 4; ++n4) Us[row * 136 + wc * 64 + n4 * 16 + l15] = ok ? f2bf(acc[mt][n4][j]) : (u16)0;
    }
  __syncthreads();
  {
    const int c8 = tid & 7, rg = tid >> 3;
    const float* cw = p.ffn_conv + (size_t)l * 3 * 2 * DFF + nt * 64 + c8 * 8;
    float wa[3][8], wg[3][8];
#pragma unroll
    for (int tp = 0; tp < 3; ++tp)
#pragma unroll
      for (int j = 0; j < 8; ++j) { wa[tp][j] = cw[tp * 2 * DFF + j]; wg[tp][j] = cw[tp * 2 * DFF + DFF + j]; }
    const u16* ua = Us + (rg * 4) * 136 + c8 * 8;
    float am[8], a0[8], a1[8], gm[8], g0[8], g1[8];
    unpack8(*(const u32x4*)ua, am); unpack8(*(const u32x4*)(ua + 64), gm);
    unpack8(*(const u32x4*)(ua + 136), a0); unpack8(*(const u32x4*)(ua + 136 + 64), g0);
#pragma unroll
    for (int k = 0; k < 4; ++k) {
      const int rr = rg * 4 + 1 + k;
      if (rr <= 126) {
        unpack8(*(const u32x4*)(ua + (k + 2) * 136), a1); unpack8(*(const u32x4*)(ua + (k + 2) * 136 + 64), g1);
        float o[8];
#pragma unroll
        for (int j = 0; j < 8; ++j) {
          float ca = wa[0][j] * am[j] + wa[1][j] * a0[j] + wa[2][j] * a1[j];
          float cgv = wg[0][j] * gm[j] + wg[1][j] * g0[j] + wg[2][j] * g1[j];
          o[j] = silu_fast(cgv) * ca;
          am[j] = a0[j]; a0[j] = a1[j]; gm[j] = g0[j]; g0[j] = g1[j];
        }
        const int pos = p0 - 1 + rr;
        if (pos < len) *(u32x4*)(act + (size_t)(seqbase + pos) * DFF + nt * 64 + c8 * 8) = pack8(o);
      }
    }
  }
}

__device__ __forceinline__ void ffn_up_tile256(const Params& p, int l, int rt, int nt, char* smem) {
  const int tid = otid(), lane = tid & 63, wid = tid >> 6, wr = wid >> 1, wc = wid & 1, l15 = lane & 15, quad = lane >> 4;
  u16* act = (u16*)(p.ws + OFF_ACT);
  int sbase, slen, smask, ti;
  if (rt < 130) { sbase = 0; slen = TX; smask = SEQ - 1; ti = rt; } else { sbase = TX; slen = TZ; smask = CTX - 1; ti = rt - 130; }
  const int g0 = ti * 254;
  char* As = smem;
  char* Bs = smem + 32768;
  f32x4 acc[8][4];
#pragma unroll
  for (int i = 0; i < 8; ++i)
#pragma unroll
    for (int j = 0; j < 4; ++j) acc[i][j] = f32x4{0.f, 0.f, 0.f, 0.f};
  const u16* Ab = (const u16*)(p.ws + OFF_HA) + ((ptrdiff_t)sbase + g0 - 1) * D;
  const u16* Bb = (const u16*)(p.ws + OFF_WUP) + (size_t)nt * 128 * D;
  const int srow = tid >> 3, sslot = tid & 7;
  const unsigned aoff = (unsigned)srow * D + sslot * 8;
  const int wsw = srow * 128 + ((sslot ^ ((srow >> 1) & 7)) << 4);
  const int sw = l15 >> 1;
  const int ro0 = ((quad ^ sw) << 4), ro1 = (((4 + quad) ^ sw) << 4);
  const char* ard = As + (wr * 128 + l15) * 128;
  const char* brd = Bs + (wc * 64 + l15) * 128;
  u32x4 ra[8], rb[4];
#pragma unroll
  for (int i = 0; i < 8; ++i) ra[i] = *(const u32x4*)(Ab + (ptrdiff_t)i * 32 * D + aoff);
#pragma unroll
  for (int i = 0; i < 4; ++i) rb[i] = *(const u32x4*)(Bb + (size_t)i * 32 * D + aoff);
  for (int k0 = 0; k0 < D; k0 += 64) {
    __syncthreads();
#pragma unroll
    for (int i = 0; i < 8; ++i) *(u32x4*)(As + wsw + i * 4096) = ra[i];
#pragma unroll
    for (int i = 0; i < 4; ++i) *(u32x4*)(Bs + wsw + i * 4096) = rb[i];
    __syncthreads();
    if (k0 + 64 < D) {
#pragma unroll
      for (int i = 0; i < 8; ++i) ra[i] = *(const u32x4*)(Ab + (ptrdiff_t)i * 32 * D + aoff + k0 + 64);
    }
    __builtin_amdgcn_s_setprio(1);
    {
      bf16x8 b0[4], b1[4], afp[3];
#pragma unroll
      for (int n4 = 0; n4 < 4; ++n4) b0[n4] = *(const bf16x8*)(brd + n4 * 2048 + ro0);
#pragma unroll
      for (int g = 0; g < 3; ++g) afp[g] = *(const bf16x8*)(ard + g * 2048 + ro0);
      __builtin_amdgcn_sched_barrier(0);
#pragma unroll
      for (int g = 0; g < 16; ++g) {
#pragma unroll
        for (int n4 = 0; n4 < 4; ++n4) acc[g & 7][n4] = MFMA(afp[g % 3], (g < 8 ? b0[n4] : b1[n4]), acc[g & 7][n4]);
        if (g + 3 < 16) afp[g % 3] = *(const bf16x8*)(ard + ((g + 3) & 7) * 2048 + ((g + 3) < 8 ? ro0 : ro1));
        if (g >= 2 && g < 6) b1[g - 2] = *(const bf16x8*)(brd + (g - 2) * 2048 + ro1);
        if (g == 8 && k0 + 64 < D) {
#pragma unroll
          for (int i = 0; i < 4; ++i) rb[i] = *(const u32x4*)(Bb + (size_t)i * 32 * D + aoff + k0 + 64);
        }
        __builtin_amdgcn_sched_barrier(0);
      }
    }
    __builtin_amdgcn_s_setprio(0);
  }
  const int c8 = tid & 7, rg = tid >> 3;
  float wa[3][8], wg[3][8];
  {
    const float* cw = p.ffn_conv + (size_t)l * 3 * 2 * DFF + nt * 64 + c8 * 8;
#pragma unroll
    for (int tp = 0; tp < 3; ++tp)
#pragma unroll
      for (int j = 0; j < 8; ++j) { wa[tp][j] = cw[tp * 2 * DFF + j]; wg[tp][j] = cw[tp * 2 * DFF + DFF + j]; }
  }
  __syncthreads();
  u16* Us = (u16*)smem;
#pragma unroll
  for (int mt = 0; mt < 8; ++mt)
#pragma unroll
    for (int j = 0; j < 4; ++j) {
      const int row = wr * 128 + mt * 16 + quad * 4 + j;
#pragma unroll
      for (int n4 = 0; n4 < 4; ++n4) Us[row * 136 + wc * 64 + n4 * 16 + l15] = f2bf(acc[mt][n4][j]);
    }
  __syncthreads();
  {
    const u16* ua = Us + (rg * 8) * 136 + c8 * 8;
    float am[8], a0[8], a1[8], gm[8], g0v[8], g1[8];
    unpack8(*(const u32x4*)ua, am); unpack8(*(const u32x4*)(ua + 64), gm);
    unpack8(*(const u32x4*)(ua + 136), a0); unpack8(*(const u32x4*)(ua + 136 + 64), g0v);
#pragma unroll
    for (int k = 0; k < 8; ++k) {
      const int rr = rg * 8 + 1 + k;
      if (rr <= 254) {
        unpack8(*(const u32x4*)(ua + (k + 2) * 136), a1); unpack8(*(const u32x4*)(ua + (k + 2) * 136 + 64), g1);
        const int g = g0 - 1 + rr;
        const int pos = g & smask;
        const bool pok = pos != 0, nok = pos != smask;
        float o[8];
#pragma unroll
        for (int j = 0; j < 8; ++j) {
          float ca = wa[1][j] * a0[j] + (pok ? wa[0][j] * am[j] : 0.f) + (nok ? wa[2][j] * a1[j] : 0.f);
          float cgv = wg[1][j] * g0v[j] + (pok ? wg[0][j] * gm[j] : 0.f) + (nok ? wg[2][j] * g1[j] : 0.f);
          o[j] = silu_fast(cgv) * ca;
          am[j] = a0[j]; a0[j] = a1[j]; gm[j] = g0v[j]; g0v[j] = g1[j];
        }
        if (g < slen) *(u32x4*)(act + (size_t)(sbase + g) * DFF + nt * 64 + c8 * 8) = pack8(o);
      }
    }
  }
}

__device__ __forceinline__ void ffn_up_phase(const Params& p, int l, int RT, char* smem) {
  const int total = RT * 44;
  for (int t = blockIdx.x; t < total; t += gridDim.x) {
    const int g = t / (16 * 44), rem = t - g * (16 * 44);
    const int gsz = (RT - g * 16) < 16 ? (RT - g * 16) : 16;
    const int rt = g * 16 + rem % gsz, nt = rem / gsz;
    if (nt < 44) ffn_up_tile256(p, l, rt, nt, smem);
  }
}

__device__ __forceinline__ void cvt_tile(const float* __restrict__ src, int K, int N, u16* __restrict__ dst, int kt, int nt, char* smem) {
  float* tile = (float*)smem;
  const int tid = otid();
  __syncthreads();
  for (int i = tid; i < 64 * 16; i += 256) {
    int kr = i >> 4, c4 = (i & 15) * 4, n = nt * 64 + c4;
    float4 v = make_float4(0.f, 0.f, 0.f, 0.f);
    if (n < N) v = *(const float4*)(src + (size_t)(kt * 64 + kr) * N + n);
    float* tp = tile + kr * 65 + c4;
    tp[0] = v.x; tp[1] = v.y; tp[2] = v.z; tp[3] = v.w;
  }
  __syncthreads();
  for (int i = tid; i < 64 * 8; i += 256) {
    int nr = i >> 3, k8 = (i & 7) * 8, n = nt * 64 + nr;
    if (n < N) {
      float f[8];
#pragma unroll
      for (int j = 0; j < 8; ++j) f[j] = tile[(k8 + j) * 65 + nr];
      *(u32x4*)(dst + (size_t)n * K + kt * 64 + k8) = pack8(f);
    }
  }
}

__device__ __forceinline__ int cvt_layer_tasks(const Params& p, int l, int t, char* smem) {
  const int i = l >> 1;
  const int Nin = (l & 1) ? PCD : PAB;
  const int n_in = 16 * ((Nin + 63) / 64), n_out = 16 * 16, n_up = 16 * 88, n_dn = 44 * 16;
  if (t < 0) return n_in + n_out + n_up + n_dn;
  if (t < n_in) {
    const float* src = (l & 1) ? p.cd_w_in + (size_t)i * D * PCD : p.ab_w_in + (size_t)i * D * PAB;
    cvt_tile(src, D, Nin, (u16*)(p.ws + OFF_WIN), t & 15, t >> 4, smem);
    return 0;
  }
  t -= n_in;
  if (t < n_out) {
    const float* src = (l & 1) ? p.cd_w_out + (size_t)i * D * D : p.ab_w_out + (size_t)i * D * D;
    cvt_tile(src, D, D, (u16*)(p.ws + OFF_WOUT), t & 15, t >> 4, smem);
    return 0;
  }
  t -= n_out;
  if (t < n_up) {
    const int cb = t >> 4;
    const int newrow0 = cb < 44 ? cb * 128 : (cb - 44) * 128 + 64;
    cvt_tile(p.ffn_w_up + (size_t)l * D * 2 * DFF, D, 2 * DFF, (u16*)(p.ws + OFF_WUP) + ((ptrdiff_t)newrow0 - cb * 64) * D, t & 15, cb, smem);
    return 0;
  }
  t -= n_up;
  cvt_tile(p.ffn_w_down + (size_t)l * DFF * D, DFF, D, (u16*)(p.ws + OFF_WDN), t % 44, t / 44, smem);
  return 0;
}

__device__ __forceinline__ void mods_task(const Params& p, int t, char* smem) {
  float* sc = (float*)smem;
  float* red = sc + 17 * 512;
  const int tid = otid(), l = t / 96, cb = t % 96, ks = tid >> 6, cl = tid & 63, j = cb * 64 + cl;
  float acc[17];
#pragma unroll
  for (int s = 0; s < 17; ++s) acc[s] = 0.f;
  for (int half = 0; half < 2; ++half) {
    __syncthreads();
    for (int i = tid; i < 17 * 512; i += 256) {
      int s = i >> 9, k = (i & 511) + half * 512;
      float v = s < 16 ? p.c[s * 1024 + k] : p.c_ctx[k];
      sc[i] = siluf(v);
    }
    __syncthreads();
    const float* w = p.w_mod + ((size_t)l * 1024 + half * 512 + ks * 128) * 6144 + j;
#pragma unroll 16
    for (int k = 0; k < 128; ++k) {
      float wv = w[(size_t)k * 6144];
      const float* scp = sc + ks * 128 + k;
#pragma unroll
      for (int s = 0; s < 17; ++s) acc[s] += scp[s * 512] * wv;
    }
  }
#pragma unroll
  for (int s = 0; s < 17; ++s) red[(ks * 17 + s) * 64 + cl] = acc[s];
  __syncthreads();
  float* mods = (float*)(p.ws + OFF_MODS);
  for (int i = tid; i < 17 * 64; i += 256) {
    int s = i >> 6, cc = i & 63, jj = cb * 64 + cc;
    float v = red[(0 * 17 + s) * 64 + cc] + red[(1 * 17 + s) * 64 + cc] + red[(2 * 17 + s) * 64 + cc] + red[(3 * 17 + s) * 64 + cc];
    mods[((size_t)l * 17 + s) * 6144 + jj] = v + p.b_mod[l * 6144 + jj];
  }
  __syncthreads();
}

__device__ __forceinline__ void rope_table_task(const Params& p, int t) {
  int idx = t * 256 + otid();
  int pos = idx >> 5, f = idx & 31;
  float inv = powf(10000.f, -(float)(2 * (f & 15)) / 32.f);
  float base = (f < 16) ? (float)(pos >> 6) : (float)(pos & 63);
  float ang = base * inv;
  float2 cs; cs.x = cosf(ang); cs.y = sinf(ang);
  ((float2*)(p.ws + OFF_ROPE))[idx] = cs;
}

__device__ __forceinline__ void lam_task(const Params& p) {
  int tid = otid();
  if (tid < 2) {
    const float* lp = p.diff_lambda + tid * 256;
    float s1 = 0.f, s2 = 0.f;
    for (int k = 0; k < 64; ++k) { s1 += lp[k] * lp[64 + k]; s2 += lp[128 + k] * lp[192 + k]; }
    float lam_init = 0.8f - 0.6f * expf(-0.3f * (float)(2 * tid));
    ((float*)(p.ws + OFF_LAM))[tid] = expf(s1) - expf(s2) + lam_init;
    ((float*)(p.ws + OFF_LAM))[2 + tid] = lam_init;
  }
}

__device__ __forceinline__ void h2_task(const Params& p, int table, int chunk, char* smem) {
  float* h1s = (float*)smem;
  const int tid = otid(), pp = tid >> 2, j0 = (tid & 3) * 16;
  const int i = (table == 1) ? 1 : 0, n = (table == 2) ? 256 : 2048;
  const int pos = chunk * 64 + pp;
  const float* w1 = p.hy_w1 + i * 33 * 64;
  const float* b1 = p.hy_b1 + i * 64;
  const float* w2 = p.hy_w2 + i * 64 * 64;
  const float* b2 = p.hy_b2 + i * 64;
  const float* fr = p.hy_freq + i * 2 * 64;
  float tt = (float)pos / (float)(n - 1);
  float a0 = 2.0f * 3.14159265358979323846f * (float)pos / (float)n;
  float acc[16];
#pragma unroll
  for (int j = 0; j < 16; ++j) acc[j] = b1[j0 + j] + tt * w1[j0 + j];
  for (int k = 0; k < 16; ++k) {
    float band = 1e-4f + (15.f - 1e-4f) * (float)k / 15.f;
    float ang = a0 * band;
    float cv = cosf(ang), sv = -sinf(ang);
#pragma unroll
    for (int j = 0; j < 16; ++j) acc[j] += cv * w1[(1 + k) * 64 + j0 + j] + sv * w1[(17 + k) * 64 + j0 + j];
  }
  __syncthreads();
#pragma unroll
  for (int j = 0; j < 16; ++j) h1s[pp * 65 + j0 + j] = sinf(fr[j0 + j] * acc[j]);
  __syncthreads();
#pragma unroll
  for (int j = 0; j < 16; ++j) acc[j] = b2[j0 + j];
  for (int k = 0; k < 64; ++k) {
    float hv = h1s[pp * 65 + k];
#pragma unroll
    for (int j = 0; j < 16; ++j) acc[j] += hv * w2[k * 64 + j0 + j];
  }
  float* H2 = (float*)(p.ws + OFF_H2) + (size_t)(table == 0 ? 0 : (table == 1 ? 2048 : 4096)) * 64;
#pragma unroll
  for (int j = 0; j < 16; ++j) H2[(size_t)pos * 64 + j0 + j] = sinf(fr[64 + j0 + j] * acc[j]);
}

__device__ __forceinline__ void filt_task(const Params& p, int i, int v, int o, int cb, char* smem) {
  float* red = (float*)smem;
  const int tid = otid(), col = tid & 31, dirn = col >> 4, c = cb * 16 + (col & 15), pg = tid >> 5;
  const int n = v ? 256 : 2048, FL = 2 * n + 16;
  const float* H2 = (float*)(p.ws + OFF_H2) + (size_t)(v ? 4096 : (i ? 2048 : 0)) * 64;
  u16* F = (u16*)(p.ws + (v ? OFF_FZ : OFF_FX)) + ((size_t)o * 512 + c) * FL;
  const float* w3 = p.hy_w3 + (size_t)i * 64 * 2048 + o * 1024 + dirn * 512 + c;
  float wc[64];
#pragma unroll
  for (int k = 0; k < 64; ++k) wc[k] = w3[(size_t)k * 2048];
  const float dmin = -3.0701134573253945f, dmax = -15.350567286626972f;
  float delta = fabsf(dmin + (dmax - dmin) * (float)c / 511.f);
  float ssq = 0.f;
  float* hs = (float*)smem + 256;
  for (int pos0 = 0; pos0 < n; pos0 += 64) {
    __syncthreads();
    for (int k = tid; k < 1024; k += 256) ((float4*)hs)[k] = ((const float4*)(H2 + (size_t)pos0 * 64))[k];
    __syncthreads();
    for (int pp = pg; pp < 64; pp += 8) {
      const int pos = pos0 + pp;
      const float4* hp = (const float4*)(hs + pp * 64);
      float a = 0.f;
#pragma unroll
      for (int k4 = 0; k4 < 16; ++k4) {
        float4 hv = hp[k4];
        a += hv.x * wc[4 * k4] + hv.y * wc[4 * k4 + 1] + hv.z * wc[4 * k4 + 2] + hv.w * wc[4 * k4 + 3];
      }
      float tt = (float)pos / (float)(n - 1);
      a *= expf(-tt * delta);
      if (dirn == 0) { ssq += a * a; F[n - pos] = f2bf(a); }
      else if (pos >= 1) { ssq += a * a; F[n + pos] = f2bf(a); }
    }
  }
  if (dirn == 0 && pg == 0) {
    unsigned zz = 0; asm volatile("" : "+v"(zz));
    F[0] = (u16)zz;
#pragma unroll 1
    for (int m = 2 * n; m < FL; ++m) F[m] = (u16)zz;
  }
  __syncthreads();
  red[pg * 32 + col] = ssq;
  __syncthreads();
  if (tid < 16) {
    float s = 0.f;
    for (int g = 0; g < 8; ++g) s += red[g * 32 + tid] + red[g * 32 + 16 + tid];
    ((float*)(p.ws + OFF_RN))[(v * 2 + o) * 512 + cb * 16 + tid] = rsqrtf(s + EPS);
  }
  __syncthreads();
}

constexpr int NR = 4;
__device__ __forceinline__ void row_pass(const float* __restrict__ xin, float* __restrict__ xout, const u16* __restrict__ orow,
                         const float* __restrict__ gb, const float* __restrict__ gate, const float* __restrict__ gh,
                         const float* __restrict__ shift, const float* __restrict__ scale, u16* __restrict__ hrow) {
  const int lane = otid() & 63;
  float4 xv[NR][4];
#pragma unroll
  for (int r = 0; r < NR; ++r)
#pragma unroll
    for (int i = 0; i < 4; ++i) xv[r][i] = *(const float4*)(xin + r * D + lane * 4 + 256 * i);
  if (orow) {
    float ov[NR][4][4];
    float ss[NR];
#pragma unroll
    for (int r = 0; r < NR; ++r) ss[r] = 0.f;
#pragma unroll
    for (int r = 0; r < NR; ++r)
#pragma unroll
      for (int i = 0; i < 4; ++i) {
        u32x2 u = *(const u32x2*)(orow + r * D + lane * 4 + 256 * i);
        ov[r][i][0] = lo2f(u.x); ov[r][i][1] = hi2f(u.x); ov[r][i][2] = lo2f(u.y); ov[r][i][3] = hi2f(u.y);
        ss[r] += ov[r][i][0] * ov[r][i][0] + ov[r][i][1] * ov[r][i][1] + ov[r][i][2] * ov[r][i][2] + ov[r][i][3] * ov[r][i][3];
      }
    float rs[NR];
#pragma unroll
    for (int r = 0; r < NR; ++r) rs[r] = rsqrtf(wave_sum(ss[r]) * (1.f / 1024.f) + EPS);
#pragma unroll
    for (int i = 0; i < 4; ++i) {
      float4 g = *(const float4*)(gb + lane * 4 + 256 * i);
      float4 gt = *(const float4*)(gate + lane * 4 + 256 * i);
#pragma unroll
      for (int r = 0; r < NR; ++r) {
        xv[r][i].x += gt.x * (ov[r][i][0] * rs[r] * g.x);
        xv[r][i].y += gt.y * (ov[r][i][1] * rs[r] * g.y);
        xv[r][i].z += gt.z * (ov[r][i][2] * rs[r] * g.z);
        xv[r][i].w += gt.w * (ov[r][i][3] * rs[r] * g.w);
      }
    }
  }
  if (xout) {
#pragma unroll
    for (int r = 0; r < NR; ++r)
#pragma unroll
      for (int i = 0; i < 4; ++i) *(float4*)(xout + r * D + lane * 4 + 256 * i) = xv[r][i];
  }
  if (hrow) {
    float rs[NR];
#pragma unroll
    for (int r = 0; r < NR; ++r) {
      float ss = 0.f;
#pragma unroll
      for (int i = 0; i < 4; ++i) ss += xv[r][i].x * xv[r][i].x + xv[r][i].y * xv[r][i].y + xv[r][i].z * xv[r][i].z + xv[r][i].w * xv[r][i].w;
      rs[r] = rsqrtf(wave_sum(ss) * (1.f / 1024.f) + EPS);
    }
#pragma unroll
    for (int i = 0; i < 4; ++i) {
      float4 g = *(const float4*)(gh + lane * 4 + 256 * i);
      float4 sh = *(const float4*)(shift + lane * 4 + 256 * i);
      float4 sc = *(const float4*)(scale + lane * 4 + 256 * i);
#pragma unroll
      for (int r = 0; r < NR; ++r) {
        u32x2 u;
        u.x = pack2(xv[r][i].x * rs[r] * g.x * (1.f + sc.x) + sh.x, xv[r][i].y * rs[r] * g.y * (1.f + sc.y) + sh.y);
        u.y = pack2(xv[r][i].z * rs[r] * g.z * (1.f + sc.z) + sh.z, xv[r][i].w * rs[r] * g.w * (1.f + sc.w) + sh.w);
        *(u32x2*)(hrow + r * D + lane * 4 + 256 * i) = u;
      }
    }
  }
}

__device__ __forceinline__ void row_phase(const Params& p, int kind, int l, int nrows) {
  const int wid = otid() >> 6;
  const float* mods = (const float*)(p.ws + OFF_MODS);
  float* Z = (float*)(p.ws + OFF_Z);
  u16* H = (u16*)(p.ws + OFF_HA);
  const u16* O = (const u16*)(p.ws + OFF_O);
  for (int t = blockIdx.x; t < nrows / (4 * NR); t += gridDim.x) {
    {
      int r = t * (4 * NR) + wid * NR;
      int s = r < TX ? (r >> 11) : 16;
      float* res = r < TX ? p.out + (size_t)r * D : Z + (size_t)(r - TX) * D;
      if (kind == 0) {
        const float* src = r < TX ? p.x + (size_t)r * D : p.ctx + (size_t)(r - TX) * D;
        const float* m = mods + ((size_t)0 * 17 + s) * 6144;
        row_pass(src, nullptr, nullptr, nullptr, nullptr, p.norm_g + (0 * 4 + 0) * D, m, m + D, H + (size_t)r * D);
      } else if (kind == 1) {
        const float* m = mods + ((size_t)l * 17 + s) * 6144;
        const float* xsrc = (l == 0) ? (r < TX ? p.x + (size_t)r * D : p.ctx + (size_t)(r - TX) * D) : res;
        row_pass(xsrc, res, O + (size_t)r * D, p.norm_g + (l * 4 + 1) * D, m + 2 * D, p.norm_g + (l * 4 + 2) * D,
                 m + 3 * D, m + 4 * D, H + (size_t)r * D);
      } else {
        const float* m = mods + ((size_t)l * 17 + s) * 6144;
        if (l < 3) {
          const float* m2 = mods + ((size_t)(l + 1) * 17 + s) * 6144;
          row_pass(res, res, O + (size_t)r * D, p.norm_g + (l * 4 + 3) * D, m + 5 * D, p.norm_g + ((l + 1) * 4 + 0) * D,
                   m2, m2 + D, H + (size_t)r * D);
        } else {
          row_pass(res, res, O + (size_t)r * D, p.norm_g + (l * 4 + 3) * D, m + 5 * D, nullptr, nullptr, nullptr, nullptr);
        }
      }
    }
  }
}

__device__ __forceinline__ void ffn_conv_phase(const Params& p, int l, int R0, int rows) {
  const u16* U = (const u16*)(p.ws + OFF_U);
  u16* act = (u16*)(p.ws + OFF_ACT);
  const float* cw = p.ffn_conv + (size_t)l * 3 * 2 * DFF;
  const int ntask = rows / 16 * 352 / 256;
  for (int t = blockIdx.x; t < ntask; t += gridDim.x) {
    int item = t * 256 + otid();
    int cg8 = item % 352, rb = item / 352;
    int lr0 = rb * 16, r0 = R0 + lr0;
    int pos0 = r0 < TX ? (r0 & 2047) : ((r0 - TX) & 255);
    int len = r0 < TX ? SEQ : CTX;
    bool pv = pos0 > 0, nv = pos0 + 16 < len;
    float wa[3][8], wg[3][8];
#pragma unroll
    for (int tp = 0; tp < 3; ++tp)
#pragma unroll
      for (int j = 0; j < 8; ++j) { wa[tp][j] = cw[tp * 2 * DFF + cg8 * 8 + j]; wg[tp][j] = cw[tp * 2 * DFF + DFF + cg8 * 8 + j]; }
    const u16* ua = U + (size_t)lr0 * 2 * DFF + cg8 * 8;
    const u16* ug = ua + DFF;
    float am[8], a0[8], ap[8], gm[8], g0[8], gp[8];
    if (pv) { unpack8(*(const u32x4*)(ua - 2 * DFF), am); unpack8(*(const u32x4*)(ug - 2 * DFF), gm); }
    else {
#pragma unroll
      for (int j = 0; j < 8; ++j) { am[j] = 0.f; gm[j] = 0.f; }
    }
    unpack8(*(const u32x4*)(ua), a0); unpack8(*(const u32x4*)(ug), g0);
    for (int k = 0; k < 16; ++k) {
      if (k < 15 || nv) { unpack8(*(const u32x4*)(ua + (size_t)(k + 1) * 2 * DFF), ap); unpack8(*(const u32x4*)(ug + (size_t)(k + 1) * 2 * DFF), gp); }
      else {
#pragma unroll
        for (int j = 0; j < 8; ++j) { ap[j] = 0.f; gp[j] = 0.f; }
      }
      float o[8];
#pragma unroll
      for (int j = 0; j < 8; ++j) {
        float ca = wa[0][j] * am[j] + wa[1][j] * a0[j] + wa[2][j] * ap[j];
        float cgv = wg[0][j] * gm[j] + wg[1][j] * g0[j] + wg[2][j] * gp[j];
        o[j] = siluf(cgv) * ca;
        am[j] = a0[j]; a0[j] = ap[j]; gm[j] = g0[j]; g0[j] = gp[j];
      }
      *(u32x4*)(act + (size_t)(r0 + k) * DFF + cg8 * 8) = pack8(o);
    }
  }
}

__device__ __forceinline__ void tr128(const u16* __restrict__ src, size_t sld, u16* __restrict__ dst, size_t dld, char* smem) {
  u16* tile = (u16*)smem;
  const int tid = otid(), a = tid >> 2, b16 = (tid & 3) * 16;
  __syncthreads();
  {
    const u16* sp0 = src + (size_t)a * sld + b16;
    const u16* sp1 = src + (size_t)(a + 64) * sld + b16;
    u32x4 v0 = *(const u32x4*)sp0, v1 = *(const u32x4*)(sp0 + 8), v2 = *(const u32x4*)sp1, v3 = *(const u32x4*)(sp1 + 8);
    const u16* e0 = (const u16*)&v0;
    const u16* e1 = (const u16*)&v1;
    const u16* e2 = (const u16*)&v2;
    const u16* e3 = (const u16*)&v3;
#pragma unroll
    for (int j = 0; j < 8; ++j) {
      tile[(b16 + j) * 136 + a] = e0[j]; tile[(b16 + 8 + j) * 136 + a] = e1[j];
      tile[(b16 + j) * 136 + a + 64] = e2[j]; tile[(b16 + 8 + j) * 136 + a + 64] = e3[j];
    }
  }
  __syncthreads();
  {
    const u16* tp = tile + a * 136 + 32 * (tid & 3);
    u16* dp = dst + (size_t)a * dld + 32 * (tid & 3);
#pragma unroll
    for (int k = 0; k < 4; ++k) *(u32x4*)(dp + 8 * k) = *(const u32x4*)(tp + 8 * k);
  }
}

__device__ __forceinline__ void rope_task(const Params& p, u16* P, int ldp, int col0, int nhb, int t) {
  const int tid = otid();
  u32x4 v1[4], v2[4];
#pragma unroll
  for (int k = 0; k < 4; ++k) {
    const int idx = (t * 4 + k) * 256 + tid;
    const int grp = idx & 1, part = (idx >> 1) & 1, rest = idx >> 2;
    const int hb = rest % nhb, r = rest / nhb;
    const u16* base = P + (size_t)r * ldp + col0 + hb * 64 + part * 32 + grp * 8;
    v1[k] = *(const u32x4*)base; v2[k] = *(const u32x4*)(base + 16);
  }
#pragma unroll
  for (int k = 0; k < 4; ++k) {
    const int idx = (t * 4 + k) * 256 + tid;
    const int grp = idx & 1, part = (idx >> 1) & 1, rest = idx >> 2;
    const int hb = rest % nhb, r = rest / nhb;
    const int pos = r & 2047;
    u16* base = P + (size_t)r * ldp + col0 + hb * 64 + part * 32 + grp * 8;
    float x1[8], x2[8], o1[8], o2[8];
    unpack8(v1[k], x1); unpack8(v2[k], x2);
    const float2* cs = (const float2*)(p.ws + OFF_ROPE) + pos * 32 + part * 16 + grp * 8;
#pragma unroll
    for (int j = 0; j < 8; ++j) {
      float2 c = cs[j];
      o1[j] = x1[j] * c.x - x2[j] * c.y;
      o2[j] = x2[j] * c.x + x1[j] * c.y;
    }
    *(u32x4*)base = pack8(o1);
    *(u32x4*)(base + 16) = pack8(o2);
  }
}

__device__ __forceinline__ void ut_task(const Params& p, int i, int rtp, int ct, char* smem) {
  u16* tile = (u16*)smem;
  const u16* P = (const u16*)(p.ws + OFF_BIG);
  u16* UT = (u16*)(p.ws + OFF_UT);
  const int tid = otid(), a = tid >> 2, b16 = (tid & 3) * 16;
  const int cc0 = ct * 64 + b16;
  const float* cw = p.hy_conv + (size_t)i * 3 * 1536 + cc0;
  float w[3][16];
#pragma unroll
  for (int tp = 0; tp < 3; ++tp)
#pragma unroll
    for (int q = 0; q < 4; ++q) {
      float4 wv = *(const float4*)(cw + tp * 1536 + 4 * q);
      w[tp][4 * q] = wv.x; w[tp][4 * q + 1] = wv.y; w[tp][4 * q + 2] = wv.z; w[tp][4 * q + 3] = wv.w;
    }
  u32x4 v[2][3][2];
  bool ok[2][3];
#pragma unroll
  for (int h = 0; h < 2; ++h) {
    const int r = rtp * 128 + h * 64 + a;
    const int pos = r < TX ? (r & 2047) : ((r - TX) & 255);
    const int len = r < TX ? SEQ : CTX;
#pragma unroll
    for (int tp = 0; tp < 3; ++tp) {
      const int pp = pos + tp - 1;
      ok[h][tp] = pp >= 0 && pp < len;
      const u16* sp = P + (size_t)(ok[h][tp] ? r + tp - 1 : r) * PCD + 768 + cc0;
      v[h][tp][0] = *(const u32x4*)sp; v[h][tp][1] = *(const u32x4*)(sp + 8);
    }
  }
  __syncthreads();
#pragma unroll
  for (int h = 0; h < 2; ++h) {
    float acc[16];
#pragma unroll
    for (int j = 0; j < 16; ++j) acc[j] = 0.f;
#pragma unroll
    for (int tp = 0; tp < 3; ++tp) {
      float f[16];
      unpack8(v[h][tp][0], f); unpack8(v[h][tp][1], f + 8);
#pragma unroll
      for (int j = 0; j < 16; ++j) acc[j] += ok[h][tp] ? w[tp][j] * f[j] : 0.f;
    }
#pragma unroll
    for (int j = 0; j < 16; ++j) tile[(b16 + j) * 136 + a + 64 * h] = f2bf(acc[j]);
  }
  __syncthreads();
  {
    const u16* tp = tile + a * 136 + 32 * (tid & 3);
    u16* dp = UT + (size_t)(ct * 64 + a) * TT + rtp * 128 + 32 * (tid & 3);
#pragma unroll
    for (int k = 0; k < 4; ++k) *(u32x4*)(dp + 8 * k) = *(const u32x4*)(tp + 8 * k);
  }
}

template <int E, bool MASK>
__device__ __forceinline__ void flash_pass(const u16* __restrict__ P, int ldp, int qrow0, int qcol, int kcol, int xrow0, int zrow0,
                                           const u16* __restrict__ Vt, int t0lo, int t0hi, int qpos0, float m_init, float l_init,
                                           f32x4 (&o)[2][E / 16], char* smem) {
  const int tid = otid(), lane = tid & 63, l15 = lane & 15, quad = lane >> 4;
  u16* Ks = (u16*)smem;
  u16* Vs = Ks + 64 * 72;
  bf16x8 qf[2][2];
#pragma unroll
  for (int qt = 0; qt < 2; ++qt)
#pragma unroll
    for (int ks = 0; ks < 2; ++ks) {
      u32x4 v = *(const u32x4*)(P + (size_t)(qrow0 + 16 * qt + l15) * ldp + qcol + 32 * ks + 8 * quad);
      float f[8];
      unpack8(v, f);
#pragma unroll
      for (int j = 0; j < 8; ++j) f[j] *= 0.125f;
      qf[qt][ks] = as_bf8(pack8(f));
    }
  float m[2] = {m_init, m_init}, l[2] = {l_init, l_init};
#pragma unroll
  for (int qt = 0; qt < 2; ++qt)
#pragma unroll
    for (int et = 0; et < E / 16; ++et) o[qt][et] = f32x4{0.f, 0.f, 0.f, 0.f};
  const int ntx = t0hi - t0lo, ntiles = ntx + 4;
  u32x4 kr[2], vr[E / 32];
  auto gload = [&](int it) {
    int kt = it < ntx ? t0lo + it : 32 + (it - ntx);
    int rbase = kt < 32 ? xrow0 + kt * 64 : zrow0 + (kt - 32) * 64;
#pragma unroll
    for (int i = 0; i < 2; ++i) {
      int idx = tid + 256 * i, key = idx >> 3, c8 = idx & 7;
      kr[i] = *(const u32x4*)(P + (size_t)(rbase + key) * ldp + kcol + c8 * 8);
    }
#pragma unroll
    for (int i = 0; i < E / 32; ++i) {
      int idx = tid + 256 * i, e = idx >> 3, c8 = idx & 7;
      vr[i] = *(const u32x4*)(Vt + (size_t)e * NKEY + kt * 64 + c8 * 8);
    }
  };
  gload(0);
  for (int it = 0; it < ntiles; ++it) {
    __syncthreads();
#pragma unroll
    for (int i = 0; i < 2; ++i) {
      int idx = tid + 256 * i, key = idx >> 3, c8 = idx & 7;
      *(u32x4*)(Ks + key * 72 + c8 * 8) = kr[i];
    }
#pragma unroll
    for (int i = 0; i < E / 32; ++i) {
      int idx = tid + 256 * i, e = idx >> 3, c8 = idx & 7;
      *(u32x4*)(Vs + e * 72 + c8 * 8) = vr[i];
    }
    __syncthreads();
    if (it + 1 < ntiles) gload(it + 1);
    f32x4 s[4][2];
#pragma unroll
    for (int k4 = 0; k4 < 4; ++k4) {
      s[k4][0] = f32x4{0.f, 0.f, 0.f, 0.f};
      s[k4][1] = f32x4{0.f, 0.f, 0.f, 0.f};
#pragma unroll
      for (int ks = 0; ks < 2; ++ks) {
        bf16x8 a = *(const bf16x8*)(Ks + (16 * k4 + l15) * 72 + 32 * ks + 8 * quad);
        s[k4][0] = MFMA(a, qf[0][ks], s[k4][0]);
        s[k4][1] = MFMA(a, qf[1][ks], s[k4][1]);
      }
    }
    if (MASK && it < ntx) {
      int kbase = (t0lo + it) * 64 + 4 * quad;
#pragma unroll
      for (int k4 = 0; k4 < 4; ++k4)
#pragma unroll
        for (int qt = 0; qt < 2; ++qt)
#pragma unroll
          for (int j = 0; j < 4; ++j) {
            int dlt = (qpos0 + 16 * qt + l15) - (kbase + 16 * k4 + j);
            if (dlt > 128 || dlt < -128) s[k4][qt][j] = -1e30f;
          }
    }
#pragma unroll
    for (int qt = 0; qt < 2; ++qt) {
      float mx = -1e30f;
#pragma unroll
      for (int k4 = 0; k4 < 4; ++k4)
#pragma unroll
        for (int j = 0; j < 4; ++j) mx = fmaxf(mx, s[k4][qt][j]);
      mx = fmaxf(mx, __shfl_xor(mx, 16));
      mx = fmaxf(mx, __shfl_xor(mx, 32));
      const float L2E = 1.4426950408889634f;
      float mn = fmaxf(m[qt], mx);
      float alpha = __builtin_amdgcn_exp2f((m[qt] - mn) * L2E);
      m[qt] = mn;
      const float mn2 = -mn * L2E;
      float sum = 0.f;
#pragma unroll
      for (int k4 = 0; k4 < 4; ++k4)
#pragma unroll
        for (int j = 0; j < 4; ++j) {
          float pv = __builtin_amdgcn_exp2f(fmaf(s[k4][qt][j], L2E, mn2));
          s[k4][qt][j] = pv;
          sum += pv;
        }
      sum += __shfl_xor(sum, 16);
      sum += __shfl_xor(sum, 32);
      l[qt] = l[qt] * alpha + sum;
      if (__any(alpha != 1.f)) {
#pragma unroll
        for (int j = 0; j < 4; ++j) {
          float aj = __shfl(alpha, 4 * quad + j);
#pragma unroll
          for (int et = 0; et < E / 16; ++et) o[qt][et][j] *= aj;
        }
      }
    }
#pragma unroll
    for (int kg = 0; kg < 2; ++kg) {
      bf16x8 pf[2];
#pragma unroll
      for (int qt = 0; qt < 2; ++qt) {
        u32x4 u;
        u.x = pack2(s[2 * kg][qt][0], s[2 * kg][qt][1]);
        u.y = pack2(s[2 * kg][qt][2], s[2 * kg][qt][3]);
        u.z = pack2(s[2 * kg + 1][qt][0], s[2 * kg + 1][qt][1]);
        u.w = pack2(s[2 * kg + 1][qt][2], s[2 * kg + 1][qt][3]);
        pf[qt] = as_bf8(u);
      }
#pragma unroll
      for (int et = 0; et < E / 16; ++et) {
        const u16* vp = Vs + (16 * et + l15) * 72 + 32 * kg + 4 * quad;
        u32x2 b0 = *(const u32x2*)vp, b1 = *(const u32x2*)(vp + 16);
        bf16x8 bv = as_bf8(mk4(b0.x, b0.y, b1.x, b1.y));
        o[0][et] = MFMA(pf[0], bv, o[0][et]);
        o[1][et] = MFMA(pf[1], bv, o[1][et]);
      }
    }
  }
#pragma unroll
  for (int qt = 0; qt < 2; ++qt) {
    float inv = 1.f / l[qt];
#pragma unroll
    for (int j = 0; j < 4; ++j) {
      float ij = __shfl(inv, 4 * quad + j);
#pragma unroll
      for (int et = 0; et < E / 16; ++et) o[qt][et][j] *= ij;
    }
  }
}

__device__ __forceinline__ void diff_task(const Params& p, int li, int task, char* smem) {
  const int qb = task % 18, h = (task / 18) & 3, b = task / 72;
  const int tid = otid(), lane = tid & 63, wid = tid >> 6, l15 = lane & 15, quad = lane >> 4;
  const u16* P = (const u16*)(p.ws + OFF_BIG);
  const u16* Vt = (const u16*)(p.ws + OFF_VTD) + (size_t)((b * 4 + h) * 128) * NKEY;
  u16* Aout = (u16*)(p.ws + OFF_HA);
  const bool isx = qb < 16;
  const int qrow0 = (isx ? b * SEQ + qb * 128 : TX + b * CTX + (qb - 16) * 128) + 32 * wid;
  const float lam = ((const float*)(p.ws + OFF_LAM))[li];
  const float lam_init = ((const float*)(p.ws + OFF_LAM))[2 + li];
  unsigned* o0s = (unsigned*)(smem + 27648) + wid * 32 * 64 + lane;
  f32x4 o[2][8];
#pragma unroll 1
  for (int t = 0; t < 2; ++t) {
    flash_pass<128, false>(P, PAB, qrow0, 2080 + h * 128 + t * 64, 2592 + h * 128 + t * 64, b * SEQ, TX + b * CTX, Vt,
                           0, isx ? 32 : 0, 0, -1e30f, 0.f, o, smem);
    if (t == 0) {
#pragma unroll
      for (int qt = 0; qt < 2; ++qt)
#pragma unroll
        for (int et = 0; et < 8; ++et) {
          o0s[((qt * 8 + et) * 2 + 0) * 64] = pack2(o[qt][et][0], o[qt][et][1]);
          o0s[((qt * 8 + et) * 2 + 1) * 64] = pack2(o[qt][et][2], o[qt][et][3]);
        }
    }
  }
  const float* g = p.diff_norm_g + li * 128;
#pragma unroll
  for (int qt = 0; qt < 2; ++qt) {
    float ss[4] = {0.f, 0.f, 0.f, 0.f};
#pragma unroll
    for (int et = 0; et < 8; ++et) {
      unsigned w0 = o0s[((qt * 8 + et) * 2 + 0) * 64], w1 = o0s[((qt * 8 + et) * 2 + 1) * 64];
      float a0 = lo2f(w0), a1 = hi2f(w0), a2 = lo2f(w1), a3 = hi2f(w1);
      o[qt][et][0] = a0 - lam * o[qt][et][0];
      o[qt][et][1] = a1 - lam * o[qt][et][1];
      o[qt][et][2] = a2 - lam * o[qt][et][2];
      o[qt][et][3] = a3 - lam * o[qt][et][3];
#pragma unroll
      for (int j = 0; j < 4; ++j) ss[j] += o[qt][et][j] * o[qt][et][j];
    }
#pragma unroll
    for (int j = 0; j < 4; ++j) {
      float v = ss[j];
      v += __shfl_xor(v, 1); v += __shfl_xor(v, 2); v += __shfl_xor(v, 4); v += __shfl_xor(v, 8);
      float rs = rsqrtf(v * (1.f / 128.f) + EPS) * (1.f - lam_init);
      int row = qrow0 + 16 * qt + 4 * quad + j;
#pragma unroll
      for (int et = 0; et < 8; ++et) {
        int e = 16 * et + l15;
        Aout[(size_t)row * D + 512 + h * 128 + e] = f2bf(o[qt][et][j] * rs * g[e]);
      }
    }
  }
}

__device__ __forceinline__ void swa_task(const Params& p, int i, int task, char* smem) {
  const int qb = task % 18, hq = (task / 18) & 7, b = task / 144;
  const int tid = otid(), lane = tid & 63, wid = tid >> 6, l15 = lane & 15, quad = lane >> 4;
  const u16* P = (const u16*)(p.ws + OFF_BIG);
  const int kv = hq >> 2;
  const u16* Vt = (const u16*)(p.ws + OFF_VTS) + (size_t)((b * 2 + kv) * 64) * NKEY;
  u16* Aout = (u16*)(p.ws + OFF_HA);
  const bool isx = qb < 16;
  const int qrow0 = (isx ? b * SEQ + qb * 128 : TX + b * CTX + (qb - 16) * 128) + 32 * wid;
  const float sink = p.swa_sink[i * 8 + hq];
  int lo = 0, hi = 0;
  if (isx) { lo = qb * 2 - 2; if (lo < 0) lo = 0; hi = qb * 2 + 4; if (hi > 32) hi = 32; }
  f32x4 o[2][4];
  flash_pass<64, true>(P, PCD, qrow0, hq * 64, 512 + kv * 64, b * SEQ, TX + b * CTX, Vt, lo, hi, qb * 128 + 32 * wid, sink, 1.f, o, smem);
#pragma unroll
  for (int qt = 0; qt < 2; ++qt)
#pragma unroll
    for (int j = 0; j < 4; ++j) {
      int row = qrow0 + 16 * qt + 4 * quad + j;
#pragma unroll
      for (int et = 0; et < 4; ++et) Aout[(size_t)row * D + hq * 64 + 16 * et + l15] = f2bf(o[qt][et][j]);
    }
}

constexpr size_t OFF_HALO = OFF_XBAR + 16384;
static_assert(OFF_HALO + (size_t)576 * 2 * 1536 * 2 <= (size_t)512 * 1024 * 1024, "ws");

__device__ __forceinline__ void halo_task(const Params& p, int ch) {
  const int tid = otid();
  if (tid >= 192) return;
  const u16* P = (const u16*)(p.ws + OFF_BIG);
  u16* HB = (u16*)(p.ws + OFF_HALO) + (size_t)ch * 2 * 1536;
  const int r0 = ch * 64;
  const int pos0 = r0 < TX ? (r0 & 2047) : ((r0 - TX) & 255);
  const int len = r0 < TX ? SEQ : CTX;
  u32x4 z = mk4(0, 0, 0, 0);
  u32x4 a = pos0 > 0 ? *(const u32x4*)(P + (size_t)(r0 - 1) * PAB + tid * 8) : z;
  u32x4 b = pos0 + 64 < len ? *(const u32x4*)(P + (size_t)(r0 + 64) * PAB + tid * 8) : z;
  *(u32x4*)(HB + tid * 8) = a;
  *(u32x4*)(HB + 1536 + tid * 8) = b;
}

__device__ __forceinline__ void qkvconv_task(const Params& p, int li, int t) {
  const int ch = t >> 3, h = t & 7;
  const int tid = otid(), i = tid >> 2, dd = (tid & 3) * 16;
  u16* P = (u16*)(p.ws + OFF_BIG);
  const u16* HB = (const u16*)(p.ws + OFF_HALO) + (size_t)ch * 2 * 1536;
  const float* cw = p.gdn_conv + (size_t)li * 3 * 1536;
  const int r = ch * 64 + i;
  float qv[16], kv[16], vv[16];
#pragma unroll
  for (int j = 0; j < 16; ++j) { qv[j] = 0.f; kv[j] = 0.f; vv[j] = 0.f; }
#pragma unroll
  for (int tp = 0; tp < 3; ++tp) {
    const u16* rp;
    if (tp == 0) rp = (i > 0) ? P + (size_t)(r - 1) * PAB : HB;
    else if (tp == 1) rp = P + (size_t)r * PAB;
    else rp = (i < 63) ? P + (size_t)(r + 1) * PAB : HB + 1536;
    rp += h * 64 + dd;
    const float* wq = cw + tp * 1536 + h * 64 + dd;
    float f[16];
    unpack8(*(const u32x4*)rp, f); unpack8(*(const u32x4*)(rp + 8), f + 8);
#pragma unroll
    for (int j = 0; j < 16; ++j) qv[j] += wq[j] * f[j];
    unpack8(*(const u32x4*)(rp + 512), f); unpack8(*(const u32x4*)(rp + 520), f + 8);
#pragma unroll
    for (int j = 0; j < 16; ++j) kv[j] += wq[512 + j] * f[j];
    unpack8(*(const u32x4*)(rp + 1024), f); unpack8(*(const u32x4*)(rp + 1032), f + 8);
#pragma unroll
    for (int j = 0; j < 16; ++j) vv[j] += wq[1024 + j] * f[j];
  }
  float sq = 0.f, sk = 0.f;
#pragma unroll
  for (int j = 0; j < 16; ++j) {
    qv[j] = silu_fast(qv[j]); kv[j] = silu_fast(kv[j]); vv[j] = silu_fast(vv[j]);
    sq += qv[j] * qv[j]; sk += kv[j] * kv[j];
  }
  sq += __shfl_xor(sq, 1); sq += __shfl_xor(sq, 2);
  sk += __shfl_xor(sk, 1); sk += __shfl_xor(sk, 2);
  float rq = rsqrtf(sq + EPS) * 0.125f, rk = rsqrtf(sk + EPS);
#pragma unroll
  for (int j = 0; j < 16; ++j) { qv[j] *= rq; kv[j] *= rk; }
  u32x4 o0 = pack8(qv), o1 = pack8(qv + 8), o2 = pack8(kv), o3 = pack8(kv + 8), o4 = pack8(vv), o5 = pack8(vv + 8);
  __syncthreads();
  u16* wp = P + (size_t)r * PAB + h * 64 + dd;
  *(u32x4*)wp = o0; *(u32x4*)(wp + 8) = o1;
  *(u32x4*)(wp + 512) = o2; *(u32x4*)(wp + 520) = o3;
  *(u32x4*)(wp + 1024) = o4; *(u32x4*)(wp + 1032) = o5;
}

#define MFMA32(a, b, c) __builtin_amdgcn_mfma_f32_16x16x4f32(a, b, c, 0, 0, 0)
__device__ __forceinline__ void gdn_chain(const Params& p, int li, int task, char* smem) {
  const int b = task >> 4, h = (task >> 1) & 7, dir = task & 1;
  u16* qs = (u16*)smem;
  u16* ks = qs + 4608;
  u16* vs = ks + 4608;
  float* Af = (float*)(vs + 4608);
  u16* vnT = (u16*)Af;
  u16* qkb = (u16*)(Af + 4096);
  u16* ktT = qkb + 4608;
  u16* Sb = ktT + 4608;
  float* sm = (float*)(Sb + 4608);
  u16* wb = ks;
  u16* ubT = vs;
  const u16* P = (const u16*)(p.ws + OFF_BIG);
  u16* Od = (u16*)(p.ws + OFF_O) + (size_t)dir * TT * 512;
  const float a_neg = -expf(p.gdn_a_log[li * 16 + dir * 8 + h]);
  const float dtb = p.gdn_dt_bias[li * 16 + dir * 8 + h];
  f32x4 S[4];
#pragma unroll
  for (int et = 0; et < 4; ++et) S[et] = f32x4{0.f, 0.f, 0.f, 0.f};
  __syncthreads();
  for (int i = otid(); i < 4608; i += 256) Sb[i] = 0;
  u32x4 pq0, pq1, pk0, pk1, pv0, pv1;
  float ppb = 0.f, ppa = 0.f;
  {
    const int tid = otid(), i = tid >> 2, dd = (tid & 3) * 16, lane = tid & 63;
    const int pos = dir ? (CTX - 1 - i) : i;
    const u16* rp = P + (size_t)(TX + b * CTX + pos) * PAB + h * 64 + dd;
    pq0 = *(const u32x4*)rp; pq1 = *(const u32x4*)(rp + 8);
    pk0 = *(const u32x4*)(rp + 512); pk1 = *(const u32x4*)(rp + 520);
    pv0 = *(const u32x4*)(rp + 1024); pv1 = *(const u32x4*)(rp + 1032);
    if (tid < 64) {
      const int pos2 = dir ? (CTX - 1 - lane) : lane;
      const u16* gp = P + (size_t)(TX + b * CTX + pos2) * PAB;
      ppb = bf2f(gp[2048 + dir * 8 + h]); ppa = bf2f(gp[2064 + dir * 8 + h]);
    }
  }
  __builtin_amdgcn_s_setprio(2);
  for (int n = 0; n < 36; ++n) {
    const int tid = otid(), lane = tid & 63, wid = tid >> 6, l15 = lane & 15, quad = lane >> 4;
    const int rowbase = n < 4 ? TX + b * CTX : b * SEQ;
    const int L = n < 4 ? CTX : SEQ;
    const int cn = n < 4 ? n : n - 4;
    {
      const int i = tid >> 2, dd = (tid & 3) * 16;
      *(u32x4*)(qs + i * 72 + dd) = pq0; *(u32x4*)(qs + i * 72 + dd + 8) = pq1;
      *(u32x4*)(ks + i * 72 + dd) = pk0; *(u32x4*)(ks + i * 72 + dd + 8) = pk1;
      *(u32x4*)(vs + i * 72 + dd) = pv0; *(u32x4*)(vs + i * 72 + dd + 8) = pv1;
      if (wid == 0) {
        float beta = 1.f / (1.f + expf(-ppb));
        float xa = ppa + dtb;
        float sp = xa > 20.f ? xa : log1pf(expf(xa));
        float g = a_neg * sp;
        float gcs = g;
#pragma unroll
        for (int o = 1; o < 64; o <<= 1) {
          float t = __shfl_up(gcs, o);
          if (lane >= o) gcs += t;
        }
        float gl = __shfl(gcs, 63);
        sm[lane] = gcs; sm[64 + lane] = beta; sm[128 + lane] = expf(gcs); sm[192 + lane] = expf(gl - gcs);
      }
      if (n + 1 < 36) {
        const int n1 = n + 1;
        const int rb1 = n1 < 4 ? TX + b * CTX : b * SEQ, L1 = n1 < 4 ? CTX : SEQ, cn1 = n1 < 4 ? n1 : n1 - 4;
        const int sidx = cn1 * 64 + i;
        const int pos = dir ? (L1 - 1 - sidx) : sidx;
        const u16* rp = P + (size_t)(rb1 + pos) * PAB + h * 64 + dd;
        pq0 = *(const u32x4*)rp; pq1 = *(const u32x4*)(rp + 8);
        pk0 = *(const u32x4*)(rp + 512); pk1 = *(const u32x4*)(rp + 520);
        pv0 = *(const u32x4*)(rp + 1024); pv1 = *(const u32x4*)(rp + 1032);
        if (wid == 0) {
          const int sidx2 = cn1 * 64 + lane;
          const int pos2 = dir ? (L1 - 1 - sidx2) : sidx2;
          const u16* gp = P + (size_t)(rb1 + pos2) * PAB;
          ppb = bf2f(gp[2048 + dir * 8 + h]); ppa = bf2f(gp[2064 + dir * 8 + h]);
        }
      }
    }
    __syncthreads();
    {
      bf16x8 ka[2], qa[2];
#pragma unroll
      for (int s2 = 0; s2 < 2; ++s2) {
        ka[s2] = *(const bf16x8*)(ks + (16 * wid + l15) * 72 + 32 * s2 + 8 * quad);
        qa[s2] = *(const bf16x8*)(qs + (16 * wid + l15) * 72 + 32 * s2 + 8 * quad);
      }
#pragma unroll
      for (int jt = 0; jt < 4; ++jt) {
        f32x4 kk = f32x4{0.f, 0.f, 0.f, 0.f}, qq = f32x4{0.f, 0.f, 0.f, 0.f};
        if (jt <= wid) {
#pragma unroll
          for (int s2 = 0; s2 < 2; ++s2) {
            bf16x8 kb = *(const bf16x8*)(ks + (16 * jt + l15) * 72 + 32 * s2 + 8 * quad);
            kk = MFMA(ka[s2], kb, kk);
            qq = MFMA(qa[s2], kb, qq);
          }
        }
        const int jj = 16 * jt + l15;
        const float gj = sm[jj];
#pragma unroll
        for (int j = 0; j < 4; ++j) {
          const int ii = 16 * wid + 4 * quad + j;
          float dg = sm[ii] - gj;
          float dec = __builtin_amdgcn_exp2f(1.4426950408889634f * fminf(dg, 0.f));
          Af[ii * 64 + jj] = (ii > jj) ? kk[j] * sm[64 + ii] * dec : 0.f;
          qkb[ii * 72 + jj] = f2bf((ii >= jj) ? qq[j] * dec : 0.f);
        }
      }
    }
    __syncthreads();
    f32x4 R[2][4];
    {
      const int c0 = 32 * (wid & 1) + l15;
#pragma unroll
      for (int ct = 0; ct < 2; ++ct)
#pragma unroll
        for (int I = 0; I < 4; ++I)
#pragma unroll
          for (int j = 0; j < 4; ++j) {
            const int row = 16 * I + 4 * quad + j;
            const float bt = sm[64 + row];
            R[ct][I][j] = (wid < 2) ? bf2f(vs[row * 72 + c0 + 16 * ct]) * bt : bf2f(ks[row * 72 + c0 + 16 * ct]) * bt * sm[128 + row];
          }
    }
    if (wid == 0) {
      const int blk = quad, col = l15;
      const float* ab = Af + (16 * blk) * 64 + 16 * blk;
      float t[16];
#pragma unroll
      for (int i = 0; i < 16; ++i) t[i] = (i == col) ? 1.f : 0.f;
#pragma unroll
      for (int i = 1; i < 16; ++i) {
        float sacc = 0.f;
#pragma unroll
        for (int j4 = 0; j4 < (i + 3) / 4; ++j4) {
          float4 a = *(const float4*)(ab + i * 64 + 4 * j4);
          if (4 * j4 + 0 < i) sacc += a.x * t[4 * j4 + 0];
          if (4 * j4 + 1 < i) sacc += a.y * t[4 * j4 + 1];
          if (4 * j4 + 2 < i) sacc += a.z * t[4 * j4 + 2];
          if (4 * j4 + 3 < i) sacc += a.w * t[4 * j4 + 3];
        }
        t[i] = (i > col) ? -sacc : t[i];
      }
      float* tb = Af + (16 * blk) * 64 + 16 * blk + col;
#pragma unroll
      for (int i = 0; i < 16; ++i) tb[i * 64] = t[i];
    } else if (wid >= 2) {
      const int tt = tid - 128, i = tt >> 1, d0 = (tt & 1) * 32;
      const float eg = sm[128 + i], etl = sm[192 + i];
#pragma unroll
      for (int q4 = 0; q4 < 4; ++q4) {
        float f[8];
        unpack8(*(const u32x4*)(qs + i * 72 + d0 + q4 * 8), f);
#pragma unroll
        for (int j = 0; j < 8; ++j) f[j] *= eg;
        *(u32x4*)(qs + i * 72 + d0 + q4 * 8) = pack8(f);
        unpack8(*(const u32x4*)(ks + i * 72 + d0 + q4 * 8), f);
#pragma unroll
        for (int j = 0; j < 8; ++j) ktT[(d0 + q4 * 8 + j) * 72 + i] = f2bf(f[j] * etl);
      }
    }
    const float egl = sm[128 + 63];
    __syncthreads();
    {
      f32x4 X[2][4];
#pragma unroll
      for (int I = 0; I < 4; ++I) {
        f32x4 y0 = R[0][I], y1 = R[1][I];
#pragma unroll
        for (int J = 0; J < I; ++J) {
          float4 av = *(const float4*)(Af + (16 * I + l15) * 64 + 16 * J + 4 * quad);
          y0 = MFMA32(-av.x, X[0][J][0], y0); y1 = MFMA32(-av.x, X[1][J][0], y1);
          y0 = MFMA32(-av.y, X[0][J][1], y0); y1 = MFMA32(-av.y, X[1][J][1], y1);
          y0 = MFMA32(-av.z, X[0][J][2], y0); y1 = MFMA32(-av.z, X[1][J][2], y1);
          y0 = MFMA32(-av.w, X[0][J][3], y0); y1 = MFMA32(-av.w, X[1][J][3], y1);
        }
        float4 tv = *(const float4*)(Af + (16 * I + l15) * 64 + 16 * I + 4 * quad);
        f32x4 x0 = f32x4{0.f, 0.f, 0.f, 0.f}, x1 = f32x4{0.f, 0.f, 0.f, 0.f};
        x0 = MFMA32(tv.x, y0[0], x0); x1 = MFMA32(tv.x, y1[0], x1);
        x0 = MFMA32(tv.y, y0[1], x0); x1 = MFMA32(tv.y, y1[1], x1);
        x0 = MFMA32(tv.z, y0[2], x0); x1 = MFMA32(tv.z, y1[2], x1);
        x0 = MFMA32(tv.w, y0[3], x0); x1 = MFMA32(tv.w, y1[3], x1);
        X[0][I] = x0; X[1][I] = x1;
      }
      const int c0 = 32 * (wid & 1) + l15;
#pragma unroll
      for (int ct = 0; ct < 2; ++ct)
#pragma unroll
        for (int I = 0; I < 4; ++I) {
          if (wid < 2) {
            u32x2 uu;
            uu.x = pack2(X[ct][I][0], X[ct][I][1]); uu.y = pack2(X[ct][I][2], X[ct][I][3]);
            *(u32x2*)(ubT + (c0 + 16 * ct) * 72 + 16 * I + 4 * quad) = uu;
          } else {
#pragma unroll
            for (int j = 0; j < 4; ++j) wb[(16 * I + 4 * quad + j) * 72 + c0 + 16 * ct] = f2bf(X[ct][I][j]);
          }
        }
    }
    __syncthreads();
    f32x4 oacc[4];
    {
      bf16x8 wa[2], qa[2];
#pragma unroll
      for (int s2 = 0; s2 < 2; ++s2) {
        wa[s2] = *(const bf16x8*)(wb + (16 * wid + l15) * 72 + 32 * s2 + 8 * quad);
        qa[s2] = *(const bf16x8*)(qs + (16 * wid + l15) * 72 + 32 * s2 + 8 * quad);
      }
#pragma unroll
      for (int et = 0; et < 4; ++et) {
        f32x4 t1 = f32x4{0.f, 0.f, 0.f, 0.f};
        oacc[et] = f32x4{0.f, 0.f, 0.f, 0.f};
#pragma unroll
        for (int s2 = 0; s2 < 2; ++s2) {
          bf16x8 sb = *(const bf16x8*)(Sb + (16 * et + l15) * 72 + 32 * s2 + 8 * quad);
          t1 = MFMA(wa[s2], sb, t1);
          oacc[et] = MFMA(qa[s2], sb, oacc[et]);
        }
        u32x2 uu = *(const u32x2*)(ubT + (16 * et + l15) * 72 + 16 * wid + 4 * quad);
        u32x2 vn;
        vn.x = pack2(lo2f(uu.x) - t1[0], hi2f(uu.x) - t1[1]);
        vn.y = pack2(lo2f(uu.y) - t1[2], hi2f(uu.y) - t1[3]);
        *(u32x2*)(vnT + (16 * et + l15) * 72 + 16 * wid + 4 * quad) = vn;
      }
    }
    __syncthreads();
    {
      bf16x8 qa[2], ka[2];
#pragma unroll
      for (int s2 = 0; s2 < 2; ++s2) {
        qa[s2] = *(const bf16x8*)(qkb + (16 * wid + l15) * 72 + 32 * s2 + 8 * quad);
        ka[s2] = *(const bf16x8*)(ktT + (16 * wid + l15) * 72 + 32 * s2 + 8 * quad);
      }
#pragma unroll
      for (int et = 0; et < 4; ++et) {
        f32x4 sn = S[et] * egl;
#pragma unroll
        for (int s2 = 0; s2 < 2; ++s2) {
          bf16x8 vb = *(const bf16x8*)(vnT + (16 * et + l15) * 72 + 32 * s2 + 8 * quad);
          oacc[et] = MFMA(qa[s2], vb, oacc[et]);
          sn = MFMA(ka[s2], vb, sn);
        }
        S[et] = sn;
        u32x2 sp;
        sp.x = pack2(sn[0], sn[1]); sp.y = pack2(sn[2], sn[3]);
        *(u32x2*)(Sb + (16 * et + l15) * 72 + 16 * wid + 4 * quad) = sp;
#pragma unroll
        for (int j = 0; j < 4; ++j) {
          const int sidx = cn * 64 + 16 * wid + 4 * quad + j;
          const int pos = dir ? (L - 1 - sidx) : sidx;
          Od[(size_t)(rowbase + pos) * 512 + h * 64 + 16 * et + l15] = f2bf(oacc[et][j]);
        }
      }
    }
  }
  __builtin_amdgcn_s_setprio(0);
  __syncthreads();
}

__device__ __forceinline__ void gdn_out_task(const Params& p, int li, int t) {
  const int tid = otid();
  const u16* OF = (const u16*)(p.ws + OFF_O);
  const u16* OB = OF + (size_t)TT * 512;
  const u16* P = (const u16*)(p.ws + OFF_BIG);
  u16* Aout = (u16*)(p.ws + OFF_HA);
  u32x4 va[4], vb[4], vg[4];
#pragma unroll
  for (int k = 0; k < 4; ++k) {
    const int idx = (t * 4 + k) * 256 + tid;
    const int r = idx >> 6, h = (idx >> 3) & 7, g8 = idx & 7;
    va[k] = *(const u32x4*)(OF + (size_t)r * 512 + h * 64 + g8 * 8);
    vb[k] = *(const u32x4*)(OB + (size_t)r * 512 + h * 64 + g8 * 8);
    vg[k] = *(const u32x4*)(P + (size_t)r * PAB + 1536 + h * 64 + g8 * 8);
  }
  const float* g = p.gdn_norm_g + li * 64 + (tid & 7) * 8;
#pragma unroll
  for (int k = 0; k < 4; ++k) {
    const int idx = (t * 4 + k) * 256 + tid;
    const int r = idx >> 6, h = (idx >> 3) & 7, g8 = idx & 7;
    float a[8], bb[8], gt[8], o[8];
    unpack8(va[k], a); unpack8(vb[k], bb); unpack8(vg[k], gt);
    float ss = 0.f;
#pragma unroll
    for (int j = 0; j < 8; ++j) { a[j] += bb[j]; ss += a[j] * a[j]; }
    ss += __shfl_xor(ss, 1); ss += __shfl_xor(ss, 2); ss += __shfl_xor(ss, 4);
    float rs = rsqrtf(ss * (1.f / 64.f) + EPS);
#pragma unroll
    for (int j = 0; j < 8; ++j) o[j] = a[j] * rs * g[j] * silu_fast(gt[j]);
    *(u32x4*)(Aout + (size_t)r * D + h * 64 + g8 * 8) = pack8(o);
  }
}

__device__ __forceinline__ void hyena_task(const Params& p, int i, int c, int v, char* smem, int dump = 0) {
  const int n = v ? CTX : SEQ, rbase = v ? TX : 0, FL = 2 * n + 16;
  const int tid = otid(), lane = tid & 63, wid = tid >> 6, l15 = lane & 15, quad = lane >> 4;
  u16* Re = (u16*)smem;
  u16* Ro = Re + (2 * SEQ + 32);
  u16* UT = (u16*)(p.ws + OFF_UT);
  u16* YT = (u16*)(p.ws + OFF_O);
  const float* rn = (const float*)(p.ws + OFF_RN) + v * 1024;
  const float* bias = p.hy_bias + (size_t)i * 1024;
  for (int o = 0; o < 2; ++o) {
    const u16* R = (const u16*)(p.ws + (v ? OFF_FZ : OFF_FX)) + ((size_t)o * 512 + c) * FL;
    __syncthreads();
    __builtin_amdgcn_fence(__ATOMIC_ACQUIRE, "workgroup");
    for (int k = tid; k < FL / 8; k += 256) ((u32x4*)Re)[k] = ((const u32x4*)R)[k];
    __syncthreads();
    for (int k = tid; k < FL - 1; k += 256) Ro[k] = Re[k + 1];
    __syncthreads();
    const u16* src = (o == 0 ? UT + (size_t)c * TT : YT + (size_t)c * TT) + rbase;
    const u16* gate = UT + (size_t)((o + 1) * 512 + c) * TT + rbase;
    u16* dst = (o == 0 ? YT + (size_t)c * TT : (dump ? YT + (size_t)(512 + c) * TT : UT + (size_t)c * TT)) + rbase;
    const float bo = bias[o * 512 + c], rno = rn[o * 512 + c];
    const int nss = n / 32;
    for (int ps = wid; ps < n / 256; ps += 4) {
      const int tbase = ps * 256;
      f32x4 acc[16];
      u32x4 afr[16];
#pragma unroll
      for (int f = 0; f < 16; ++f) acc[f] = f32x4{0.f, 0.f, 0.f, 0.f};
      const u16* cp = ((l15 & 1) ? Ro : Re) + (n - tbase - l15 + 8 * quad - (l15 & 1));
#define LDA(f) ({ const uint32_t* q_ = (const uint32_t*)(cp - 16 * (f)); mk4(q_[0], q_[1], q_[2], q_[3]); })
#pragma unroll
      for (int f = 0; f < 16; ++f) afr[f] = LDA(f);
      const u16* bp = src + (size_t)l15 * n + 8 * quad;
      u32x4 bq[8];
#pragma unroll
      for (int k = 0; k < 8; ++k) bq[k] = *(const u32x4*)(bp + 32 * k);
      for (int ss8 = 0; ss8 < nss; ss8 += 8) {
#pragma unroll
        for (int u = 0; u < 8; ++u) {
          const int ss = ss8 + u;
          if (u > 0 || ss8 > 0) {
            afr[(16 - 2 * u) & 15] = LDA(-2 * ss);
            afr[(17 - 2 * u) & 15] = LDA(-2 * ss + 1);
          }
          bf16x8 bb = as_bf8(bq[u]);
          if (ss + 8 < nss) bq[u] = *(const u32x4*)(bp + 32 * (ss + 8));
#pragma unroll
          for (int tt = 0; tt < 16; ++tt) acc[tt] = MFMA(as_bf8(afr[(tt - 2 * u) & 15]), bb, acc[tt]);
        }
      }
#undef LDA
#pragma unroll
      for (int tt = 0; tt < 16; ++tt) {
        const size_t off = (size_t)l15 * n + tbase + 16 * tt + 4 * quad;
        u32x2 sv = *(const u32x2*)(src + off), gv = *(const u32x2*)(gate + off);
        u32x2 ov;
        ov.x = pack2(lo2f(gv.x) * (acc[tt][0] * rno + lo2f(sv.x) * bo), hi2f(gv.x) * (acc[tt][1] * rno + hi2f(sv.x) * bo));
        ov.y = pack2(lo2f(gv.y) * (acc[tt][2] * rno + lo2f(sv.y) * bo), hi2f(gv.y) * (acc[tt][3] * rno + hi2f(sv.y) * bo));
        *(u32x2*)(dst + off) = ov;
      }
    }
    __builtin_amdgcn_fence(__ATOMIC_RELEASE, "workgroup");
  }
  __syncthreads();
}

#define XB_TMO      128
#define XB_XCNT(j)  (256  + 64 * (j))
#define XB_XSUB(j)  (1280 + 64 * (j))
#define XB_XGEN(j)  (2304 + 64 * (j))
#define XB_TOP      3328
#define XB_TOPGEN   3392
#define XCD_BAR_WORDS 3456
#define XB_SPIN_CAP (1u << 18)
#define LAS __attribute__((address_space(3)))

__device__ __forceinline__ unsigned xb_ld(unsigned* p)              { return __hip_atomic_load(p, __ATOMIC_RELAXED, __HIP_MEMORY_SCOPE_AGENT); }
__device__ __forceinline__ unsigned xb_add(unsigned* p, unsigned v) { return __hip_atomic_fetch_add(p, v, __ATOMIC_RELAXED, __HIP_MEMORY_SCOPE_AGENT); }
__device__ __forceinline__ unsigned xb_xcc_id() { return (unsigned)__builtin_amdgcn_s_getreg((3 << 11) | 20) & 0xFu; }
#define XB_SPIN(cond, bar) do { unsigned _sp = 0; while (cond) { __builtin_amdgcn_s_sleep(1); \
    if ((++_sp & 255u) == 0u) { if (xb_ld(&(bar)[XB_TMO])) break; if (_sp > XB_SPIN_CAP) { atomicAdd(&(bar)[XB_TMO], 1u); break; } } } } while (0)

struct XcdBarrier {
    unsigned* bar; unsigned x;
    volatile LAS unsigned* st;
};

__device__ __forceinline__ XcdBarrier xcd_barrier_post(unsigned* bar, volatile LAS unsigned* st) {
    XcdBarrier b; b.bar = bar; b.x = xb_xcc_id(); b.st = st;
    if (threadIdx.x == 0) (void)xb_add(&bar[XB_XCNT(b.x)], 1u);
    return b;
}
__device__ __forceinline__ void xcd_barrier_complete(unsigned* bar, unsigned x, unsigned& nloc, unsigned& nx) {
    const unsigned G = gridDim.x * gridDim.y * gridDim.z;
    unsigned sum, cnt, mine, sp = 0u;
    for (;;) {
        sum = 0u; cnt = 0u; mine = 0u;
#pragma unroll
        for (unsigned j = 0; j < 16; ++j) { const unsigned c = xb_ld(&bar[XB_XCNT(j)]); sum += c; cnt += (c > 0u) ? 1u : 0u; mine = (j == x) ? c : mine; }
        if (sum == G) break;
        __builtin_amdgcn_s_sleep(1);
        if ((++sp & 255u) == 0u) { if (xb_ld(&bar[XB_TMO])) break; if (sp > XB_SPIN_CAP) { atomicAdd(&bar[XB_TMO], 1u); break; } }
    }
    nloc = mine > 0u ? mine : 1u; nx = cnt > 0u ? cnt : 1u;
}

__device__ __forceinline__ void xcd_barrier(const XcdBarrier& b) {
    asm volatile("s_waitcnt vmcnt(0)" ::: "memory");
    __syncthreads();
    if (threadIdx.x == 0) {
        unsigned* bar = b.bar;
        __builtin_amdgcn_s_waitcnt(0);
        unsigned nloc = b.st[0], nx = b.st[1];
        if (nloc == 0u) { xcd_barrier_complete(bar, b.x, nloc, nx); b.st[0] = nloc; b.st[1] = nx; }
        const unsigned old = xb_add(&bar[XB_XSUB(b.x)], 1u);
        const unsigned gen = old / nloc;
        if (old + 1u == (gen + 1u) * nloc) {
            __builtin_amdgcn_fence(__ATOMIC_RELEASE, "agent");
            asm volatile("s_waitcnt vmcnt(0)" ::: "memory");
            const unsigned og = xb_add(&bar[XB_TOP], 1u);
            const unsigned tg = og / nx;
            if (og + 1u == (tg + 1u) * nx) xb_add(&bar[XB_TOPGEN], 1u);
            else XB_SPIN(xb_ld(&bar[XB_TOPGEN]) == tg, bar);
            __builtin_amdgcn_fence(__ATOMIC_ACQUIRE, "agent");
            xb_add(&bar[XB_XGEN(b.x)], 1u);
            asm volatile("s_waitcnt vmcnt(0)" ::: "memory");
        } else {
            XB_SPIN(xb_ld(&bar[XB_XGEN(b.x)]) == gen, bar);
            __builtin_amdgcn_fence(__ATOMIC_ACQUIRE, "agent");
            asm volatile("s_waitcnt vmcnt(0)" ::: "memory");
        }
    }
    __syncthreads();
}


constexpr int NPHASES = 2 + 10 + 10 + 10 + 10;

__device__ __forceinline__ int grab(int* cnt, int* s_task) {
  __syncthreads();
  if (threadIdx.x == 0) *s_task = atomicAdd(cnt, 1);
  __syncthreads();
  return *s_task;
}

__global__ void __launch_bounds__(256, 2) __attribute__((amdgpu_waves_per_eu(2, 2))) mega(Params p) {
  extern __shared__ __attribute__((aligned(16))) char smem[];
  __shared__ uint4 sh_words;
  if (threadIdx.x == 0) sh_words = make_uint4(0u, 0u, 0u, 0u);
  __syncthreads();
  int& s_task = *(int*)&sh_words.z;
  XcdBarrier xb = xcd_barrier_post((unsigned*)(p.ws + OFF_XBAR), (volatile LAS unsigned*)&sh_words);
  cg::grid_group grid = cg::this_grid();
  const int G = gridDim.x, B = blockIdx.x;
  int ph = 0;
#define RUN (ph >= p.ph_lo && ph < p.ph_hi)
#define NEXT do { ++ph; if (ph > p.ph_lo && ph < p.ph_hi) { if (ph == 1) grid.sync(); else xcd_barrier(xb); } } while (0)
  u16* H = (u16*)(p.ws + OFF_HA);
  u16* O = (u16*)(p.ws + OFF_O);
  u16* BIG = (u16*)(p.ws + OFF_BIG);
  int* cnt = (int*)(p.ws + OFF_CNT);

  if (RUN) {
    const int n_cvt = cvt_layer_tasks(p, 0, -1, smem);
    const int total = 384 + 256 + 1 + 68 + n_cvt;
    for (int rep = 0; rep < PREP; ++rep)
    for (int t = B; t < total; t += G) {
      int u = t;
      if (u < 384) { mods_task(p, u, smem); continue; }
      u -= 384;
      if (u < 256) { rope_table_task(p, u); continue; }
      u -= 256;
      if (u < 1) { lam_task(p); continue; }
      u -= 1;
      if (u < 68) { if (u < 32) h2_task(p, 0, u, smem); else if (u < 64) h2_task(p, 1, u - 32, smem); else h2_task(p, 2, u - 64, smem); continue; }
      u -= 68;
      cvt_layer_tasks(p, 0, u, smem);
    }
  }
  NEXT;
  if (RUN) row_phase(p, 0, 0, TT);
  NEXT;

  for (int l = 0; l < 4; ++l) {
    const bool last = (l == 3);
    const int li = l >> 1;
    const int Nin = (l & 1) ? PCD : PAB;
    if (RUN) gemm_phase(H, D, (const u16*)(p.ws + OFF_WIN), D, BIG, Nin, TT, Nin, D, smem);
    NEXT;
    if (RUN) {
      if (!(l & 1)) {
        const int n_rope = TX * 16 * 4 / 1024, n_vt = 16 * 4 * 2 * 18, n_halo = TT / 64;
        for (int rep = 0; rep < PREP; ++rep)
        for (int t = B; t < n_rope + n_vt + n_halo; t += G) {
          if (t < n_rope) { if (rep == 0) rope_task(p, BIG, PAB, 2080, 16, t); }
          else if (t >= n_rope + n_vt) halo_task(p, t - n_rope - n_vt);
          else {
            int u = t - n_rope;
            int kt = 2 * (u % 18), eh = (u / 18) & 1, h = (u / 36) & 3, b = u / 144;
            int row = kt < 32 ? b * SEQ + kt * 64 : TX + b * CTX + (kt - 32) * 64;
            tr128(BIG + (size_t)row * PAB + 3104 + h * 128 + eh * 64, PAB,
                 (u16*)(p.ws + OFF_VTD) + (size_t)((b * 4 + h) * 128 + eh * 64) * NKEY + kt * 64, NKEY, smem);
          }
        }
      } else {
        const int n_rope = TX * 10 * 4 / 1024, n_vt = 16 * 2 * 18, nrt = last ? TX / 64 : TT / 64, n_ut = (nrt / 2) * 24;
        for (int rep = 0; rep < PREP; ++rep)
        for (int t = B; t < n_rope + n_vt + n_ut; t += G) {
          if (t < n_rope) { if (rep == 0) rope_task(p, BIG, PCD, 0, 10, t); }
          else if (t < n_rope + n_vt) {
            int u = t - n_rope;
            int kt = 2 * (u % 18), kv = (u / 18) & 1, b = u / 36;
            int row = kt < 32 ? b * SEQ + kt * 64 : TX + b * CTX + (kt - 32) * 64;
            tr128(BIG + (size_t)row * PCD + 640 + kv * 64, PCD,
                 (u16*)(p.ws + OFF_VTS) + (size_t)((b * 2 + kv) * 64) * NKEY + kt * 64, NKEY, smem);
          } else {
            int u = t - n_rope - n_vt;
            ut_task(p, li, u / 24, u % 24, smem);
          }
        }
      }
    }
    NEXT;
    if (RUN) {
      if (!(l & 1)) for (int t = B; t < TT / 64 * 8; t += G) qkvconv_task(p, li, t);
    }
    NEXT;
    if (RUN) {
      if (!(l & 1)) {
        const int n_filt = (l == 0) ? 128 : 64;
        const int total = 256 + 1152 + n_filt;
#ifdef PROBE_MIX
        for (;;) {
          int t = grab(cnt + ph + 200, &s_task);
          if (PROBE_MIX == 1) { if (t >= 1152) break; diff_task(p, li, t, smem); }
          else { if (t >= 256) break; gdn_chain(p, li, t, smem); }
        }
        xcd_barrier(xb);
#endif
        for (;;) {
          int t = grab(cnt + ph, &s_task);
          if (t >= total) break;
          if (t < 256) gdn_chain(p, li, t, smem);
          else if (t < 1408) diff_task(p, li, t - 256, smem);
          else { const int u = t - 1408; filt_task(p, (l + 1) >> 1, u >> 6, (u >> 5) & 1, u & 31, smem); }
        }
      } else {
        const int n_hy = last ? 512 : 1024, n_swa = last ? 2048 : 2304;
#ifdef PROBE_HY
        for (;;) {
          int t = grab(cnt + ph + 200, &s_task);
          if (PROBE_HY == 1) { if (t >= n_hy) break; hyena_task(p, li, t & 511, t >> 9, smem, 1); }
          else {
            if (t >= n_swa) break;
            int u = t;
            if (last) { int qb = u & 15, hq = (u >> 4) & 7, b = u >> 7; u = b * 144 + hq * 18 + qb; }
            swa_task(p, li, u, smem);
          }
        }
        xcd_barrier(xb);
#endif
        for (;;) {
          int t = grab(cnt + ph, &s_task);
          if (t >= n_hy + n_swa) break;
#ifndef NO_HY
          if (t < n_hy) hyena_task(p, li, t & 511, t >> 9, smem);
          else
#endif
          {
            int u = t - n_hy;
            if (last) { int qb = u & 15, hq = (u >> 4) & 7, b = u >> 7; u = b * 144 + hq * 18 + qb; }
#ifndef NO_SWA
            swa_task(p, li, u, smem);
#endif
          }
        }
      }
    }
    NEXT;
    if (RUN) {
      if (!(l & 1)) {
        for (int rep = 0; rep < PREP; ++rep)
        for (int t = B; t < TT * 64 / 1024; t += G) gdn_out_task(p, li, t);
      } else {
        const int nrt = last ? TX / 64 : TT / 64;
        for (int rep = 0; rep < PREP; ++rep)
        for (int t = B; t < nrt * 4; t += G) {
          int rt = t >> 2, ct = 2 * (t & 3);
          tr128((const u16*)(p.ws + OFF_UT) + (size_t)(ct * 64) * TT + rt * 64, TT, H + (size_t)(rt * 64) * D + 512 + ct * 64, D, smem);
        }
      }
    }
    NEXT;
    if (RUN) gemm_phase(H, D, (const u16*)(p.ws + OFF_WOUT), D, O, D, last ? TX : TT, D, D, smem);
    NEXT;
    if (RUN) row_phase(p, 1, l, last ? TX : TT);
    NEXT;
    const int nc_in = 16 * (((((l + 1) & 1) ? PCD : PAB) + 63) / 64), nc_io = nc_in + 256, nc_up = 1408;
    if (RUN) {
      ffn_up_phase(p, l, last ? 130 : 147, smem);
      if (!last) for (;;) { const int t = grab(cnt + ph, &s_task); if (t >= nc_io) break; cvt_layer_tasks(p, l + 1, t, smem); }
    }
    NEXT;
    if (RUN) {
      gemm_phase((const u16*)(p.ws + OFF_ACT), DFF, (const u16*)(p.ws + OFF_WDN), DFF, O, D, last ? TX : TT, D, DFF, smem);
      if (!last) for (;;) { const int t = grab(cnt + ph, &s_task); if (t >= nc_up) break; cvt_layer_tasks(p, l + 1, nc_io + t, smem); }
    }
    NEXT;
    if (RUN) {
      row_phase(p, 2, l, last ? TX : TT);
      if (!last) {
        const int n_cvt = cvt_layer_tasks(p, l + 1, -1, smem);
        const int n_f = 0;
        for (int t = nc_io + nc_up + B; t < n_cvt + n_f; t += G) {
          if (t < n_cvt) cvt_layer_tasks(p, l + 1, t, smem);
          else {
            int u = t - n_cvt;
            filt_task(p, (l + 1) >> 1, u >> 6, (u >> 5) & 1, u & 31, smem);
          }
        }
      }
    }
    NEXT;
  }
#undef RUN
#undef NEXT
}

extern "C" void kernel_launch(void* const* d_in, const int* in_sizes, int n_in, void* d_out, int out_size, void* d_ws,
                              size_t ws_size, hipStream_t stream) {
  static int grid = 0;
  if (grid == 0) {
    if (n_in != 29 || ws_size < OFF_HALO + (size_t)576 * 2 * 1536 * 2) { fprintf(stderr, "kernel_launch: unexpected n_in %d / ws %zu (need %zu)\n", n_in, ws_size, (size_t)WS_END); grid = -1; return; }
    int dev = 0, cus = 0, per_cu = 0;
    hipGetDevice(&dev);
    hipDeviceGetAttribute(&cus, hipDeviceAttributeMultiprocessorCount, dev);
    if (hipFuncSetAttribute((const void*)mega, hipFuncAttributeMaxDynamicSharedMemorySize, LDS_BYTES) != hipSuccess) { fprintf(stderr, "hipFuncSetAttribute failed\n"); grid = -1; return; }
    hipOccupancyMaxActiveBlocksPerMultiprocessor(&per_cu, (const void*)mega, 256, LDS_BYTES);
    if (per_cu < 1) { fprintf(stderr, "occupancy query returned %d\n", per_cu); per_cu = 1; }
    if (per_cu > 2) per_cu = 2;
    grid = cus * per_cu;
    fprintf(stderr, "kernel_launch: grid %d (%d CUs x %d)\n", grid, cus, per_cu);
  }
  if (grid < 0) return;
  hipMemsetAsync((char*)d_ws + OFF_CNT, 0, 4096, stream);
  hipMemsetAsync((char*)d_ws + OFF_XBAR, 0, 16384, stream);
  Params p{};
  const float** pp = (const float**)&p;
  for (int i = 0; i < 29; ++i) pp[i] = (const float*)d_in[i];
  p.out = (float*)d_out;
  p.ws = (char*)d_ws;
#if MULTI_LAUNCH
  for (int k = 0; k < NPHASES; ++k) {
    p.ph_lo = k; p.ph_hi = k + 1;
    hipLaunchKernelGGL(mega, dim3(grid), dim3(256), LDS_BYTES, stream, p);
  }
#else
  p.ph_lo = 0; p.ph_hi = NPHASES;
  void* args[] = {&p};
  hipError_t e = hipLaunchCooperativeKernel((const void*)mega, dim3(grid), dim3(256), args, LDS_BYTES, stream);
  if (e != hipSuccess) fprintf(stderr, "cooperative launch failed: %s (grid %d)\n", hipGetErrorString(e), grid);
#endif
}
```

```cpp
#include <hip/hip_runtime.h>
#include <hip/hip_cooperative_groups.h>
#include <cstdio>
#include <cstdint>
namespace cg = cooperative_groups;

typedef __attribute__((ext_vector_type(8))) short bf16x8;
typedef __attribute__((ext_vector_type(4))) float f32x4;
typedef unsigned short u16;
typedef unsigned u32x4 __attribute__((ext_vector_type(4)));
typedef unsigned u32x2 __attribute__((ext_vector_type(2)));
__device__ __forceinline__ u32x4 mk4(unsigned a, unsigned b, unsigned c, unsigned d) { u32x4 v; v.x = a; v.y = b; v.z = c; v.w = d; return v; }

#ifndef PREP
#define PREP 1
#endif
#ifndef MULTI_LAUNCH
#define MULTI_LAUNCH 0
#endif

constexpr int D = 1024, NB = 16, SEQ = 2048, CTX = 256, TX = NB * SEQ, TZ = NB * CTX, TT = TX + TZ;
constexpr int PAB = 3616, PCD = 2304, DFF = 2816, NKEY = SEQ + CTX;
constexpr float EPS = 1e-6f;
constexpr int LDS_BYTES = 73728;

constexpr size_t al(size_t x) { return (x + 255) & ~(size_t)255; }
constexpr size_t OFF_CNT = 0;
constexpr size_t OFF_LAM = 4096;
constexpr size_t OFF_ROPE = 8192;
constexpr size_t OFF_MODS = OFF_ROPE + 2048 * 32 * 8;
constexpr size_t OFF_H2 = OFF_MODS + (size_t)4 * 17 * 6144 * 4;
constexpr size_t OFF_RN = OFF_H2 + (size_t)(2048 + 2048 + 256) * 64 * 4;
constexpr int FLX = 2 * SEQ + 16, FLZ = 2 * CTX + 16;
constexpr size_t OFF_FX = OFF_RN + 2 * 2 * 512 * 4;
constexpr size_t OFF_FZ = al(OFF_FX + (size_t)2 * 512 * FLX * 2);
constexpr size_t OFF_Z = al(OFF_FZ + (size_t)2 * 512 * FLZ * 2);
constexpr size_t OFF_HA = OFF_Z + (size_t)TZ * D * 4;
constexpr size_t OFF_O = OFF_HA + (size_t)TT * D * 2;
constexpr size_t OFF_WIN = OFF_O + (size_t)TT * D * 2;
constexpr size_t OFF_WOUT = OFF_WIN + (size_t)PAB * D * 2;
constexpr size_t OFF_WUP = OFF_WOUT + (size_t)D * D * 2;
constexpr size_t OFF_WDN = OFF_WUP + (size_t)2 * DFF * D * 2;
constexpr size_t OFF_BIG = OFF_WDN + (size_t)D * DFF * 2;
constexpr size_t OFF_VTD = OFF_BIG + (size_t)TT * PAB * 2;
constexpr size_t OFF_UT = OFF_BIG + (size_t)TT * PCD * 2;
constexpr size_t OFF_VTS = OFF_UT + (size_t)1536 * TT * 2;
constexpr size_t OFF_ACT = OFF_BIG;
constexpr size_t OFF_U = OFF_BIG + (size_t)TT * DFF * 2;
constexpr size_t WS_END = OFF_VTD + (size_t)16 * 4 * 128 * NKEY * 2;
static_assert(OFF_VTS + (size_t)16 * 2 * 64 * NKEY * 2 <= WS_END, "ws");
static_assert(OFF_U + (size_t)8192 * 2 * DFF * 2 <= WS_END, "ws");
constexpr size_t OFF_XBAR = (WS_END + 255) & ~(size_t)255;
static_assert(OFF_XBAR + 16384 <= (size_t)512 * 1024 * 1024, "ws");

struct Params {
  const float *x, *c, *ctx, *c_ctx, *w_mod, *b_mod, *norm_g, *ffn_w_up, *ffn_conv, *ffn_w_down, *ab_w_in, *ab_w_out,
      *gdn_conv, *gdn_a_log, *gdn_dt_bias, *gdn_norm_g, *diff_lambda, *diff_norm_g, *cd_w_in, *cd_w_out, *swa_sink,
      *hy_conv, *hy_w1, *hy_b1, *hy_w2, *hy_b2, *hy_w3, *hy_freq, *hy_bias;
  float* out;
  char* ws;
  int ph_lo, ph_hi;
};

__device__ __forceinline__ int otid() { int t = threadIdx.x; asm volatile("" : "+v"(t)); return t; }
#define MFMA(a, b, c) __builtin_amdgcn_mfma_f32_16x16x32_bf16(a, b, c, 0, 0, 0)

typedef float f32x2_t __attribute__((ext_vector_type(2)));
typedef __bf16 bf16x2_t __attribute__((ext_vector_type(2)));
__device__ __forceinline__ u16 f2bf(float f) { __bf16 r = (__bf16)f; return __builtin_bit_cast(u16, r); }
__device__ __forceinline__ float bf2f(u16 h) { return __uint_as_float(((unsigned)h) << 16); }
__device__ __forceinline__ unsigned pack2(float a, float b) { f32x2_t v = {a, b}; bf16x2_t r = __builtin_convertvector(v, bf16x2_t); return __builtin_bit_cast(unsigned, r); }
__device__ __forceinline__ float lo2f(unsigned u) { return __uint_as_float(u << 16); }
__device__ __forceinline__ float hi2f(unsigned u) { return __uint_as_float(u & 0xffff0000u); }
__device__ __forceinline__ void unpack8(const u32x4& v, float* f) {
  f[0] = lo2f(v.x); f[1] = hi2f(v.x); f[2] = lo2f(v.y); f[3] = hi2f(v.y);
  f[4] = lo2f(v.z); f[5] = hi2f(v.z); f[6] = lo2f(v.w); f[7] = hi2f(v.w);
}
__device__ __forceinline__ u32x4 pack8(const float* f) {
  return mk4(pack2(f[0], f[1]), pack2(f[2], f[3]), pack2(f[4], f[5]), pack2(f[6], f[7]));
}
__device__ __forceinline__ bf16x8 as_bf8(const u32x4& v) {
  return __builtin_bit_cast(bf16x8, v);
}
__device__ __forceinline__ float siluf(float v) { return v / (1.f + expf(-v)); }
__device__ __forceinline__ float silu_fast(float v) { return v * __builtin_amdgcn_rcpf(1.f + __builtin_amdgcn_exp2f(-1.4426950408889634f * v)); }
__device__ __forceinline__ float wave_sum(float v) {
#pragma unroll
  for (int o = 32; o > 0; o >>= 1) v += __shfl_xor(v, o);
  return v;
}

__device__ __forceinline__ void gemm_tile(const u16* __restrict__ A, int lda, const u16* __restrict__ Bt, int ldb, u16* __restrict__ C,
                          int ldc, int m0, int n0, int N, int K, char* smem) {
  const int tid = otid(), lane = tid & 63, wid = tid >> 6, wr = wid >> 1, wc = wid & 1, l15 = lane & 15, quad = lane >> 4;
  u16* As = (u16*)smem;
  u16* Bs = As + 128 * 72;
  f32x4 acc[4][4];
#pragma unroll
  for (int i = 0; i < 4; ++i)
#pragma unroll
    for (int j = 0; j < 4; ++j) acc[i][j] = f32x4{0.f, 0.f, 0.f, 0.f};
  u32x4 ra[4], rb[4];
  const u16* ap[4];
  const u16* bp[4];
#pragma unroll
  for (int i = 0; i < 4; ++i) {
    int idx = tid + 256 * i, row = idx >> 3, c8 = idx & 7;
    ap[i] = A + (size_t)(m0 + row) * lda + c8 * 8;
    int bn = n0 + row; if (bn > N - 1) bn = N - 1;
    bp[i] = Bt + (size_t)bn * ldb + c8 * 8;
  }
#pragma unroll
  for (int i = 0; i < 4; ++i) { ra[i] = *(const u32x4*)(ap[i]); rb[i] = *(const u32x4*)(bp[i]); }
#define GEMM_STEP(RA, RB, KK) do { \
    __syncthreads(); \
    _Pragma("unroll") for (int i = 0; i < 4; ++i) { \
      int idx = tid + 256 * i, row = idx >> 3, c8 = idx & 7; \
      *(u32x4*)(As + row * 72 + c8 * 8) = RA[i]; \
      *(u32x4*)(Bs + row * 72 + c8 * 8) = RB[i]; \
    } \
    __syncthreads(); \
    if ((KK) + 64 < K) { \
      _Pragma("unroll") for (int i = 0; i < 4; ++i) { RA[i] = *(const u32x4*)(ap[i] + (KK) + 64); RB[i] = *(const u32x4*)(bp[i] + (KK) + 64); } \
    } \
    _Pragma("unroll") for (int ks = 0; ks < 2; ++ks) { \
      bf16x8 af[4], bfr[4]; \
      _Pragma("unroll") for (int mt = 0; mt < 4; ++mt) af[mt] = *(const bf16x8*)(As + (wr * 64 + mt * 16 + l15) * 72 + ks * 32 + quad * 8); \
      _Pragma("unroll") for (int n4 = 0; n4 < 4; ++n4) bfr[n4] = *(const bf16x8*)(Bs + (wc * 64 + n4 * 16 + l15) * 72 + ks * 32 + quad * 8); \
      _Pragma("unroll") for (int mt = 0; mt < 4; ++mt) \
        _Pragma("unroll") for (int n4 = 0; n4 < 4; ++n4) acc[mt][n4] = MFMA(af[mt], bfr[n4], acc[mt][n4]); \
    } \
  } while (0)
  for (int k0 = 0; k0 < K; k0 += 64) {
    GEMM_STEP(ra, rb, k0);
  }
#undef GEMM_STEP
#pragma unroll
  for (int mt = 0; mt < 4; ++mt)
#pragma unroll
    for (int nt = 0; nt < 4; ++nt) {
      int col = n0 + wc * 64 + nt * 16 + l15;
      if (col < N) {
#pragma unroll
        for (int j = 0; j < 4; ++j) {
          int row = m0 + wr * 64 + mt * 16 + quad * 4 + j;
          C[(size_t)row * ldc + col] = f2bf(acc[mt][nt][j]);
        }
      }
    }
}

__device__ __forceinline__ void gemm_tile256(const u16* __restrict__ A, int lda, const u16* __restrict__ Bt, int ldb, u16* __restrict__ C,
                                             int ldc, int m0, int n0, int N, int K, char* smem) {
  const int tid = otid(), lane = tid & 63, wid = tid >> 6, wr = wid >> 1, wc = wid & 1, l15 = lane & 15, quad = lane >> 4;
  char* As = smem;
  char* Bs = smem + 32768;
  f32x4 acc[8][4];
#pragma unroll
  for (int i = 0; i < 8; ++i)
#pragma unroll
    for (int j = 0; j < 4; ++j) acc[i][j] = f32x4{0.f, 0.f, 0.f, 0.f};
  const u16* Ab = A + (size_t)m0 * lda;
  const u16* Bb = Bt + (size_t)n0 * ldb;
  const int srow = tid >> 3, sslot = tid & 7;
  const unsigned aoff = (unsigned)srow * lda + sslot * 8;
  const unsigned boff0 = (unsigned)srow * ldb + sslot * 8;
  const int wsw = srow * 128 + ((sslot ^ ((srow >> 1) & 7)) << 4);
  const int sw = l15 >> 1;
  const int ro0 = ((quad ^ sw) << 4), ro1 = (((4 + quad) ^ sw) << 4);
  const char* ard = As + (wr * 128 + l15) * 128;
  const char* brd = Bs + (wc * 64 + l15) * 128;
  u32x4 ra[8], rb[4];
#pragma unroll
  for (int i = 0; i < 8; ++i) ra[i] = *(const u32x4*)(Ab + (size_t)i * 32 * lda + aoff);
#pragma unroll
  for (int i = 0; i < 4; ++i) rb[i] = *(const u32x4*)(Bb + (size_t)i * 32 * ldb + boff0);
  for (int k0 = 0; k0 < K; k0 += 64) {
    __syncthreads();
#pragma unroll
    for (int i = 0; i < 8; ++i) *(u32x4*)(As + wsw + i * 4096) = ra[i];
#pragma unroll
    for (int i = 0; i < 4; ++i) *(u32x4*)(Bs + wsw + i * 4096) = rb[i];
    __syncthreads();
    if (k0 + 64 < K) {
#pragma unroll
      for (int i = 0; i < 8; ++i) ra[i] = *(const u32x4*)(Ab + (size_t)i * 32 * lda + aoff + k0 + 64);
    }
    __builtin_amdgcn_s_setprio(1);
    {
      bf16x8 b0[4], b1[4], afp[3];
#pragma unroll
      for (int n4 = 0; n4 < 4; ++n4) b0[n4] = *(const bf16x8*)(brd + n4 * 2048 + ro0);
#pragma unroll
      for (int g = 0; g < 3; ++g) afp[g] = *(const bf16x8*)(ard + g * 2048 + ro0);
      __builtin_amdgcn_sched_barrier(0);
#pragma unroll
      for (int g = 0; g < 16; ++g) {
#pragma unroll
        for (int n4 = 0; n4 < 4; ++n4) acc[g & 7][n4] = MFMA(afp[g % 3], (g < 8 ? b0[n4] : b1[n4]), acc[g & 7][n4]);
        if (g + 3 < 16) afp[g % 3] = *(const bf16x8*)(ard + ((g + 3) & 7) * 2048 + ((g + 3) < 8 ? ro0 : ro1));
        if (g >= 2 && g < 6) b1[g - 2] = *(const bf16x8*)(brd + (g - 2) * 2048 + ro1);
        if (g == 8 && k0 + 64 < K) {
#pragma unroll
          for (int i = 0; i < 4; ++i) rb[i] = *(const u32x4*)(Bb + (size_t)i * 32 * ldb + boff0 + k0 + 64);
        }
        __builtin_amdgcn_sched_barrier(0);
      }
    }
    __builtin_amdgcn_s_setprio(0);
  }
#pragma unroll
  for (int mt = 0; mt < 8; ++mt)
#pragma unroll
    for (int n4 = 0; n4 < 4; ++n4) {
      int col = n0 + wc * 64 + n4 * 16 + l15;
      if (col < N) {
#pragma unroll
        for (int j = 0; j < 4; ++j) {
          int row = m0 + wr * 128 + mt * 16 + quad * 4 + j;
          C[(size_t)row * ldc + col] = f2bf(acc[mt][n4][j]);
        }
      }
    }
}

#ifndef GEMM_REP
#define GEMM_REP 1
#endif
__device__ __forceinline__ void gemm_phase(const u16* A, int lda, const u16* Bt, int ldb, u16* C, int ldc, int M, int N, int K, char* smem) {
  const int MT = M / 256, NT = (N + 127) / 128, total = MT * NT;
  const int G = gridDim.x;
  const int full = (total / G) * G;
  const int ntask = full + 2 * (total - full);
#pragma unroll 1
  for (int rep = 0; rep < GEMM_REP; ++rep)
  for (int t = blockIdx.x; t < ntask; t += G) {
    const int tile = t < full ? t : full + ((t - full) >> 1);
    int g = tile / (16 * NT), rem = tile % (16 * NT);
    int mt = g * 16 + (rem & 15), nt = rem >> 4;
    if (t < full) gemm_tile256(A, lda, Bt, ldb, C, ldc, mt * 256, nt * 128, N, K, smem);
    else gemm_tile(A, lda, Bt, ldb, C, ldc, mt * 256 + ((t - full) & 1) * 128, nt * 128, N, K, smem);
  }
}

__device__ __forceinline__ void ffn_up_tile(const Params& p, int l, int rt, int nt, char* smem) {
  const int tid = otid(), lane = tid & 63, wid = tid >> 6, wr = wid >> 1, wc = wid & 1, l15 = lane & 15, quad = lane >> 4;
  const u16* A = (const u16*)(p.ws + OFF_HA);
  const u16* Bt = (const u16*)(p.ws + OFF_WUP);
  u16* act = (u16*)(p.ws + OFF_ACT);
  int seqbase, len, p0;
  if (rt < 272) { int sq = rt / 17; seqbase = sq * SEQ; len = SEQ; p0 = (rt - sq * 17) * 126; }
  else { int q = rt - 272, sq = q / 3; seqbase = TX + sq * CTX; len = CTX; p0 = (q - sq * 3) * 126; }
  u16* As = (u16*)smem;
  u16* Bs = As + 128 * 72;
  f32x4 acc[4][4];
#pragma unroll
  for (int i = 0; i < 4; ++i)
#pragma unroll
    for (int j = 0; j < 4; ++j) acc[i][j] = f32x4{0.f, 0.f, 0.f, 0.f};
  u32x4 ra[4], rb[4];
  const u16* ap[4];
  const u16* bp[4];
#pragma unroll
  for (int i = 0; i < 4; ++i) {
    int idx = tid + 256 * i, row = idx >> 3, c8 = idx & 7;
    int pos = p0 - 1 + row;
    pos = pos < 0 ? 0 : (pos > len - 1 ? len - 1 : pos);
    ap[i] = A + (size_t)(seqbase + pos) * D + c8 * 8;
    bp[i] = Bt + (size_t)(nt * 128 + row) * D + c8 * 8;
  }
  u32x4 ra2[4], rb2[4];
#pragma unroll
  for (int i = 0; i < 4; ++i) { ra[i] = *(const u32x4*)(ap[i]); rb[i] = *(const u32x4*)(bp[i]); }
#pragma unroll
  for (int i = 0; i < 4; ++i) { ra2[i] = *(const u32x4*)(ap[i] + 64); rb2[i] = *(const u32x4*)(bp[i] + 64); }
#define GEMM_STEP(RA, RB, KK) do { \
    __syncthreads(); \
    _Pragma("unroll") for (int i = 0; i < 4; ++i) { \
      int idx = tid + 256 * i, row = idx >> 3, c8 = idx & 7; \
      *(u32x4*)(As + row * 72 + c8 * 8) = RA[i]; \
      *(u32x4*)(Bs + row * 72 + c8 * 8) = RB[i]; \
    } \
    __syncthreads(); \
    if ((KK) + 128 < D) { \
      _Pragma("unroll") for (int i = 0; i < 4; ++i) { RA[i] = *(const u32x4*)(ap[i] + (KK) + 128); RB[i] = *(const u32x4*)(bp[i] + (KK) + 128); } \
    } \
    _Pragma("unroll") for (int ks = 0; ks < 2; ++ks) { \
      bf16x8 af[4], bfr[4]; \
      _Pragma("unroll") for (int mt = 0; mt < 4; ++mt) af[mt] = *(const bf16x8*)(As + (wr * 64 + mt * 16 + l15) * 72 + ks * 32 + quad * 8); \
      _Pragma("unroll") for (int n4 = 0; n4 < 4; ++n4) bfr[n4] = *(const bf16x8*)(Bs + (wc * 64 + n4 * 16 + l15) * 72 + ks * 32 + quad * 8); \
      _Pragma("unroll") for (int mt = 0; mt < 4; ++mt) \
        _Pragma("unroll") for (int n4 = 0; n4 < 4; ++n4) acc[mt][n4] = MFMA(af[mt], bfr[n4], acc[mt][n4]); \
    } \
  } while (0)
  for (int k0 = 0; k0 < D; k0 += 128) {
    GEMM_STEP(ra, rb, k0);
    GEMM_STEP(ra2, rb2, k0 + 64);
  }
#undef GEMM_STEP
  __syncthreads();
  u16* Us = (u16*)smem;
#pragma unroll
  for (int mt = 0; mt < 4; ++mt)
#pragma unroll
    for (int j = 0; j < 4; ++j) {
      const int row = wr * 64 + mt * 16 + quad * 4 + j;
      const int pos = p0 - 1 + row;
      const bool ok = pos >= 0 && pos < len;
#pragma unroll
      for (int n4 = 0; n4 < 4; ++n4) Us[row * 136 + wc * 64 + n4 * 16 + l15] = ok ? f2bf(acc[mt][n4][j]) : (u16)0;
    }
  __syncthreads();
  {
    const int c8 = tid & 7, rg = tid >> 3;
    const float* cw = p.ffn_conv + (size_t)l * 3 * 2 * DFF + nt * 64 + c8 * 8;
    float wa[3][8], wg[3][8];
#pragma unroll
    for (int tp = 0; tp < 3; ++tp)
#pragma unroll
      for (int j = 0; j < 8; ++j) { wa[tp][j] = cw[tp * 2 * DFF + j]; wg[tp][j] = cw[tp * 2 * DFF + DFF + j]; }
    const u16* ua = Us + (rg * 4) * 136 + c8 * 8;
    float am[8], a0[8], a1[8], gm[8], g0[8], g1[8];
    unpack8(*(const u32x4*)ua, am); unpack8(*(const u32x4*)(ua + 64), gm);
    unpack8(*(const u32x4*)(ua + 136), a0); unpack8(*(const u32x4*)(ua + 136 + 64), g0);
#pragma unroll
    for (int k = 0; k < 4; ++k) {
      const int rr = rg * 4 + 1 + k;
      if (rr <= 126) {
        unpack8(*(const u32x4*)(ua + (k + 2) * 136), a1); unpack8(*(const u32x4*)(ua + (k + 2) * 136 + 64), g1);
        float o[8];
#pragma unroll
        for (int j = 0; j < 8; ++j) {
          float ca = wa[0][j] * am[j] + wa[1][j] * a0[j] + wa[2][j] * a1[j];
          float cgv = wg[0][j] * gm[j] + wg[1][j] * g0[j] + wg[2][j] * g1[j];
          o[j] = silu_fast(cgv) * ca;
          am[j] = a0[j]; a0[j] = a1[j]; gm[j] = g0[j]; g0[j] = g1[j];
        }
        const int pos = p0 - 1 + rr;
        if (pos < len) *(u32x4*)(act + (size_t)(seqbase + pos) * DFF + nt * 64 + c8 * 8) = pack8(o);
      }
    }
  }
}

__device__ __forceinline__ void ffn_up_tile256(const Params& p, int l, int rt, int nt, char* smem) {
  const int tid = otid(), lane = tid & 63, wid = tid >> 6, wr = wid >> 1, wc = wid & 1, l15 = lane & 15, quad = lane >> 4;
  u16* act = (u16*)(p.ws + OFF_ACT);
  int sbase, slen, smask, ti;
  if (rt < 130) { sbase = 0; slen = TX; smask = SEQ - 1; ti = rt; } else { sbase = TX; slen = TZ; smask = CTX - 1; ti = rt - 130; }
  const int g0 = ti * 254;
  char* As = smem;
  char* Bs = smem + 32768;
  f32x4 acc[8][4];
#pragma unroll
  for (int i = 0; i < 8; ++i)
#pragma unroll
    for (int j = 0; j < 4; ++j) acc[i][j] = f32x4{0.f, 0.f, 0.f, 0.f};
  const u16* Ab = (const u16*)(p.ws + OFF_HA) + ((ptrdiff_t)sbase + g0 - 1) * D;
  const u16* Bb = (const u16*)(p.ws + OFF_WUP) + (size_t)nt * 128 * D;
  const int srow = tid >> 3, sslot = tid & 7;
  const unsigned aoff = (unsigned)srow * D + sslot * 8;
  const int wsw = srow * 128 + ((sslot ^ ((srow >> 1) & 7)) << 4);
  const int sw = l15 >> 1;
  const int ro0 = ((quad ^ sw) << 4), ro1 = (((4 + quad) ^ sw) << 4);
  const char* ard = As + (wr * 128 + l15) * 128;
  const char* brd = Bs + (wc * 64 + l15) * 128;
  u32x4 ra[8], rb[4];
#pragma unroll
  for (int i = 0; i < 8; ++i) ra[i] = *(const u32x4*)(Ab + (ptrdiff_t)i * 32 * D + aoff);
#pragma unroll
  for (int i = 0; i < 4; ++i) rb[i] = *(const u32x4*)(Bb + (size_t)i * 32 * D + aoff);
  for (int k0 = 0; k0 < D; k0 += 64) {
    __syncthreads();
#pragma unroll
    for (int i = 0; i < 8; ++i) *(u32x4*)(As + wsw + i * 4096) = ra[i];
#pragma unroll
    for (int i = 0; i < 4; ++i) *(u32x4*)(Bs + wsw + i * 4096) = rb[i];
    __syncthreads();
    if (k0 + 64 < D) {
#pragma unroll
      for (int i = 0; i < 8; ++i) ra[i] = *(const u32x4*)(Ab + (ptrdiff_t)i * 32 * D + aoff + k0 + 64);
    }
    __builtin_amdgcn_s_setprio(1);
    {
      bf16x8 b0[4], b1[4], afp[3];
#pragma unroll
      for (int n4 = 0; n4 < 4; ++n4) b0[n4] = *(const bf16x8*)(brd + n4 * 2048 + ro0);
#pragma unroll
      for (int g = 0; g < 3; ++g) afp[g] = *(const bf16x8*)(ard + g * 2048 + ro0);
      __builtin_amdgcn_sched_barrier(0);
#pragma unroll
      for (int g = 0; g < 16; ++g) {
#pragma unroll
        for (int n4 = 0; n4 < 4; ++n4) acc[g & 7][n4] = MFMA(afp[g % 3], (g < 8 ? b0[n4] : b1[n4]), acc[g & 7][n4]);
        if (g + 3 < 16) afp[g % 3] = *(const bf16x8*)(ard + ((g + 3) & 7) * 2048 + ((g + 3) < 8 ? ro0 : ro1));
        if (g >= 2 && g < 6) b1[g - 2] = *(const bf16x8*)(brd + (g - 2) * 2048 + ro1);
        if (g == 8 && k0 + 64 < D) {
#pragma unroll
          for (int i = 0; i < 4; ++i) rb[i] = *(const u32x4*)(Bb + (size_t)i * 32 * D + aoff + k0 + 64);
        }
        __builtin_amdgcn_sched_barrier(0);
      }
    }
    __builtin_amdgcn_s_setprio(0);
  }
  const int c8 = tid & 7, rg = tid >> 3;
  float wa[3][8], wg[3][8];
  {
    const float* cw = p.ffn_conv + (size_t)l * 3 * 2 * DFF + nt * 64 + c8 * 8;
#pragma unroll
    for (int tp = 0; tp < 3; ++tp)
#pragma unroll
      for (int j = 0; j < 8; ++j) { wa[tp][j] = cw[tp * 2 * DFF + j]; wg[tp][j] = cw[tp * 2 * DFF + DFF + j]; }
  }
  __syncthreads();
  u16* Us = (u16*)smem;
#pragma unroll
  for (int mt = 0; mt < 8; ++mt)
#pragma unroll
    for (int j = 0; j < 4; ++j) {
      const int row = wr * 128 + mt * 16 + quad * 4 + j;
#pragma unroll
      for (int n4 = 0; n4 < 4; ++n4) Us[row * 136 + wc * 64 + n4 * 16 + l15] = f2bf(acc[mt][n4][j]);
    }
  __syncthreads();
  {
    const u16* ua = Us + (rg * 8) * 136 + c8 * 8;
    float am[8], a0[8], a1[8], gm[8], g0v[8], g1[8];
    unpack8(*(const u32x4*)ua, am); unpack8(*(const u32x4*)(ua + 64), gm);
    unpack8(*(const u32x4*)(ua + 136), a0); unpack8(*(const u32x4*)(ua + 136 + 64), g0v);
#pragma unroll
    for (int k = 0; k < 8; ++k) {
      const int rr = rg * 8 + 1 + k;
      if (rr <= 254) {
        unpack8(*(const u32x4*)(ua + (k + 2) * 136), a1); unpack8(*(const u32x4*)(ua + (k + 2) * 136 + 64), g1);
        const int g = g0 - 1 + rr;
        const int pos = g & smask;
        const bool pok = pos != 0, nok = pos != smask;
        float o[8];
#pragma unroll
        for (int j = 0; j < 8; ++j) {
          float ca = wa[1][j] * a0[j] + (pok ? wa[0][j] * am[j] : 0.f) + (nok ? wa[2][j] * a1[j] : 0.f);
          float cgv = wg[1][j] * g0v[j] + (pok ? wg[0][j] * gm[j] : 0.f) + (nok ? wg[2][j] * g1[j] : 0.f);
          o[j] = silu_fast(cgv) * ca;
          am[j] = a0[j]; a0[j] = a1[j]; gm[j] = g0v[j]; g0v[j] = g1[j];
        }
        if (g < slen) *(u32x4*)(act + (size_t)(sbase + g) * DFF + nt * 64 + c8 * 8) = pack8(o);
      }
    }
  }
}

__device__ __forceinline__ void ffn_up_phase(const Params& p, int l, int RT, char* smem) {
  const int total = RT * 44;
  for (int t = blockIdx.x; t < total; t += gridDim.x) {
    const int g = t / (16 * 44), rem = t - g * (16 * 44);
    const int gsz = (RT - g * 16) < 16 ? (RT - g * 16) : 16;
    const int rt = g * 16 + rem % gsz, nt = rem / gsz;
    if (nt < 44) ffn_up_tile256(p, l, rt, nt, smem);
  }
}

__device__ __forceinline__ void cvt_tile(const float* __restrict__ src, int K, int N, u16* __restrict__ dst, int kt, int nt, char* smem) {
  float* tile = (float*)smem;
  const int tid = otid();
  __syncthreads();
  for (int i = tid; i < 64 * 16; i += 256) {
    int kr = i >> 4, c4 = (i & 15) * 4, n = nt * 64 + c4;
    float4 v = make_float4(0.f, 0.f, 0.f, 0.f);
    if (n < N) v = *(const float4*)(src + (size_t)(kt * 64 + kr) * N + n);
    float* tp = tile + kr * 65 + c4;
    tp[0] = v.x; tp[1] = v.y; tp[2] = v.z; tp[3] = v.w;
  }
  __syncthreads();
  for (int i = tid; i < 64 * 8; i += 256) {
    int nr = i >> 3, k8 = (i & 7) * 8, n = nt * 64 + nr;
    if (n < N) {
      float f[8];
#pragma unroll
      for (int j = 0; j < 8; ++j) f[j] = tile[(k8 + j) * 65 + nr];
      *(u32x4*)(dst + (size_t)n * K + kt * 64 + k8) = pack8(f);
    }
  }
}

__device__ __forceinline__ int cvt_layer_tasks(const Params& p, int l, int t, char* smem) {
  const int i = l >> 1;
  const int Nin = (l & 1) ? PCD : PAB;
  const int n_in = 16 * ((Nin + 63) / 64), n_out = 16 * 16, n_up = 16 * 88, n_dn = 44 * 16;
  if (t < 0) return n_in + n_out + n_up + n_dn;
  if (t < n_in) {
    const float* src = (l & 1) ? p.cd_w_in + (size_t)i * D * PCD : p.ab_w_in + (size_t)i * D * PAB;
    cvt_tile(src, D, Nin, (u16*)(p.ws + OFF_WIN), t & 15, t >> 4, smem);
    return 0;
  }
  t -= n_in;
  if (t < n_out) {
    const float* src = (l & 1) ? p.cd_w_out + (size_t)i * D * D : p.ab_w_out + (size_t)i * D * D;
    cvt_tile(src, D, D, (u16*)(p.ws + OFF_WOUT), t & 15, t >> 4, smem);
    return 0;
  }
  t -= n_out;
  if (t < n_up) {
    const int cb = t >> 4;
    const int newrow0 = cb < 44 ? cb * 128 : (cb - 44) * 128 + 64;
    cvt_tile(p.ffn_w_up + (size_t)l * D * 2 * DFF, D, 2 * DFF, (u16*)(p.ws + OFF_WUP) + ((ptrdiff_t)newrow0 - cb * 64) * D, t & 15, cb, smem);
    return 0;
  }
  t -= n_up;
  cvt_tile(p.ffn_w_down + (size_t)l * DFF * D, DFF, D, (u16*)(p.ws + OFF_WDN), t % 44, t / 44, smem);
  return 0;
}

__device__ __forceinline__ void mods_task(const Params& p, int t, char* smem) {
  float* sc = (float*)smem;
  float* red = sc + 17 * 512;
  const int tid = otid(), l = t / 96, cb = t % 96, ks = tid >> 6, cl = tid & 63, j = cb * 64 + cl;
  float acc[17];
#pragma unroll
  for (int s = 0; s < 17; ++s) acc[s] = 0.f;
  for (int half = 0; half < 2; ++half) {
    __syncthreads();
    for (int i = tid; i < 17 * 512; i += 256) {
      int s = i >> 9, k = (i & 511) + half * 512;
      float v = s < 16 ? p.c[s * 1024 + k] : p.c_ctx[k];
      sc[i] = siluf(v);
    }
    __syncthreads();
    const float* w = p.w_mod + ((size_t)l * 1024 + half * 512 + ks * 128) * 6144 + j;
#pragma unroll 16
    for (int k = 0; k < 128; ++k) {
      float wv = w[(size_t)k * 6144];
      const float* scp = sc + ks * 128 + k;
#pragma unroll
      for (int s = 0; s < 17; ++s) acc[s] += scp[s * 512] * wv;
    }
  }
#pragma unroll
  for (int s = 0; s < 17; ++s) red[(ks * 17 + s) * 64 + cl] = acc[s];
  __syncthreads();
  float* mods = (float*)(p.ws + OFF_MODS);
  for (int i = tid; i < 17 * 64; i += 256) {
    int s = i >> 6, cc = i & 63, jj = cb * 64 + cc;
    float v = red[(0 * 17 + s) * 64 + cc] + red[(1 * 17 + s) * 64 + cc] + red[(2 * 17 + s) * 64 + cc] + red[(3 * 17 + s) * 64 + cc];
    mods[((size_t)l * 17 + s) * 6144 + jj] = v + p.b_mod[l * 6144 + jj];
  }
  __syncthreads();
}

__device__ __forceinline__ void rope_table_task(const Params& p, int t) {
  int idx = t * 256 + otid();
  int pos = idx >> 5, f = idx & 31;
  float inv = powf(10000.f, -(float)(2 * (f & 15)) / 32.f);
  float base = (f < 16) ? (float)(pos >> 6) : (float)(pos & 63);
  float ang = base * inv;
  float2 cs; cs.x = cosf(ang); cs.y = sinf(ang);
  ((float2*)(p.ws + OFF_ROPE))[idx] = cs;
}

__device__ __forceinline__ void lam_task(const Params& p) {
  int tid = otid();
  if (tid < 2) {
    const float* lp = p.diff_lambda + tid * 256;
    float s1 = 0.f, s2 = 0.f;
    for (int k = 0; k < 64; ++k) { s1 += lp[k] * lp[64 + k]; s2 += lp[128 + k] * lp[192 + k]; }
    float lam_init = 0.8f - 0.6f * expf(-0.3f * (float)(2 * tid));
    ((float*)(p.ws + OFF_LAM))[tid] = expf(s1) - expf(s2) + lam_init;
    ((float*)(p.ws + OFF_LAM))[2 + tid] = lam_init;
  }
}

__device__ __forceinline__ void h2_task(const Params& p, int table, int chunk, char* smem) {
  float* h1s = (float*)smem;
  const int tid = otid(), pp = tid >> 2, j0 = (tid & 3) * 16;
  const int i = (table == 1) ? 1 : 0, n = (table == 2) ? 256 : 2048;
  const int pos = chunk * 64 + pp;
  const float* w1 = p.hy_w1 + i * 33 * 64;
  const float* b1 = p.hy_b1 + i * 64;
  const float* w2 = p.hy_w2 + i * 64 * 64;
  const float* b2 = p.hy_b2 + i * 64;
  const float* fr = p.hy_freq + i * 2 * 64;
  float tt = (float)pos / (float)(n - 1);
  float a0 = 2.0f * 3.14159265358979323846f * (float)pos / (float)n;
  float acc[16];
#pragma unroll
  for (int j = 0; j < 16; ++j) acc[j] = b1[j0 + j] + tt * w1[j0 + j];
  for (int k = 0; k < 16; ++k) {
    float band = 1e-4f + (15.f - 1e-4f) * (float)k / 15.f;
    float ang = a0 * band;
    float cv = cosf(ang), sv = -sinf(ang);
#pragma unroll
    for (int j = 0; j < 16; ++j) acc[j] += cv * w1[(1 + k) * 64 + j0 + j] + sv * w1[(17 + k) * 64 + j0 + j];
  }
  __syncthreads();
#pragma unroll
  for (int j = 0; j < 16; ++j) h1s[pp * 65 + j0 + j] = sinf(fr[j0 + j] * acc[j]);
  __syncthreads();
#pragma unroll
  for (int j = 0; j < 16; ++j) acc[j] = b2[j0 + j];
  for (int k = 0; k < 64; ++k) {
    float hv = h1s[pp * 65 + k];
#pragma unroll
    for (int j = 0; j < 16; ++j) acc[j] += hv * w2[k * 64 + j0 + j];
  }
  float* H2 = (float*)(p.ws + OFF_H2) + (size_t)(table == 0 ? 0 : (table == 1 ? 2048 : 4096)) * 64;
#pragma unroll
  for (int j = 0; j < 16; ++j) H2[(size_t)pos * 64 + j0 + j] = sinf(fr[64 + j0 + j] * acc[j]);
}

__device__ __forceinline__ void filt_task(const Params& p, int i, int v, int o, int cb, char* smem) {
  float* red = (float*)smem;
  const int tid = otid(), col = tid & 31, dirn = col >> 4, c = cb * 16 + (col & 15), pg = tid >> 5;
  const int n = v ? 256 : 2048, FL = 2 * n + 16;
  const float* H2 = (float*)(p.ws + OFF_H2) + (size_t)(v ? 4096 : (i ? 2048 : 0)) * 64;
  u16* F = (u16*)(p.ws + (v ? OFF_FZ : OFF_FX)) + ((size_t)o * 512 + c) * FL;
  const float* w3 = p.hy_w3 + (size_t)i * 64 * 2048 + o * 1024 + dirn * 512 + c;
  float wc[64];
#pragma unroll
  for (int k = 0; k < 64; ++k) wc[k] = w3[(size_t)k * 2048];
  const float dmin = -3.0701134573253945f, dmax = -15.350567286626972f;
  float delta = fabsf(dmin + (dmax - dmin) * (float)c / 511.f);
  float ssq = 0.f;
  float* hs = (float*)smem + 256;
  for (int pos0 = 0; pos0 < n; pos0 += 64) {
    __syncthreads();
    for (int k = tid; k < 1024; k += 256) ((float4*)hs)[k] = ((const float4*)(H2 + (size_t)pos0 * 64))[k];
    __syncthreads();
    for (int pp = pg; pp < 64; pp += 8) {
      const int pos = pos0 + pp;
      const float4* hp = (const float4*)(hs + pp * 64);
      float a = 0.f;
#pragma unroll
      for (int k4 = 0; k4 < 16; ++k4) {
        float4 hv = hp[k4];
        a += hv.x * wc[4 * k4] + hv.y * wc[4 * k4 + 1] + hv.z * wc[4 * k4 + 2] + hv.w * wc[4 * k4 + 3];
      }
      float tt = (float)pos / (float)(n - 1);
      a *= expf(-tt * delta);
      if (dirn == 0) { ssq += a * a; F[n - pos] = f2bf(a); }
      else if (pos >= 1) { ssq += a * a; F[n + pos] = f2bf(a); }
    }
  }
  if (dirn == 0 && pg == 0) {
    unsigned zz = 0; asm volatile("" : "+v"(zz));
    F[0] = (u16)zz;
#pragma unroll 1
    for (int m = 2 * n; m < FL; ++m) F[m] = (u16)zz;
  }
  __syncthreads();
  red[pg * 32 + col] = ssq;
  __syncthreads();
  if (tid < 16) {
    float s = 0.f;
    for (int g = 0; g < 8; ++g) s += red[g * 32 + tid] + red[g * 32 + 16 + tid];
    ((float*)(p.ws + OFF_RN))[(v * 2 + o) * 512 + cb * 16 + tid] = rsqrtf(s + EPS);
  }
  __syncthreads();
}

constexpr int NR = 4;
__device__ __forceinline__ void row_pass(const float* __restrict__ xin, float* __restrict__ xout, const u16* __restrict__ orow,
                         const float* __restrict__ gb, const float* __restrict__ gate, const float* __restrict__ gh,
                         const float* __restrict__ shift, const float* __restrict__ scale, u16* __restrict__ hrow) {
  const int lane = otid() & 63;
  float4 xv[NR][4];
#pragma unroll
  for (int r = 0; r < NR; ++r)
#pragma unroll
    for (int i = 0; i < 4; ++i) xv[r][i] = *(const float4*)(xin + r * D + lane * 4 + 256 * i);
  if (orow) {
    float ov[NR][4][4];
    float ss[NR];
#pragma unroll
    for (int r = 0; r < NR; ++r) ss[r] = 0.f;
#pragma unroll
    for (int r = 0; r < NR; ++r)
#pragma unroll
      for (int i = 0; i < 4; ++i) {
        u32x2 u = *(const u32x2*)(orow + r * D + lane * 4 + 256 * i);
        ov[r][i][0] = lo2f(u.x); ov[r][i][1] = hi2f(u.x); ov[r][i][2] = lo2f(u.y); ov[r][i][3] = hi2f(u.y);
        ss[r] += ov[r][i][0] * ov[r][i][0] + ov[r][i][1] * ov[r][i][1] + ov[r][i][2] * ov[r][i][2] + ov[r][i][3] * ov[r][i][3];
      }
    float rs[NR];
#pragma unroll
    for (int r = 0; r < NR; ++r) rs[r] = rsqrtf(wave_sum(ss[r]) * (1.f / 1024.f) + EPS);
#pragma unroll
    for (int i = 0; i < 4; ++i) {
      float4 g = *(const float4*)(gb + lane * 4 + 256 * i);
      float4 gt = *(const float4*)(gate + lane * 4 + 256 * i);
#pragma unroll
      for (int r = 0; r < NR; ++r) {
        xv[r][i].x += gt.x * (ov[r][i][0] * rs[r] * g.x);
        xv[r][i].y += gt.y * (ov[r][i][1] * rs[r] * g.y);
        xv[r][i].z += gt.z * (ov[r][i][2] * rs[r] * g.z);
        xv[r][i].w += gt.w * (ov[r][i][3] * rs[r] * g.w);
      }
    }
  }
  if (xout) {
#pragma unroll
    for (int r = 0; r < NR; ++r)
#pragma unroll
      for (int i = 0; i < 4; ++i) *(float4*)(xout + r * D + lane * 4 + 256 * i) = xv[r][i];
  }
  if (hrow) {
    float rs[NR];
#pragma unroll
    for (int r = 0; r < NR; ++r) {
      float ss = 0.f;
#pragma unroll
      for (int i = 0; i < 4; ++i) ss += xv[r][i].x * xv[r][i].x + xv[r][i].y * xv[r][i].y + xv[r][i].z * xv[r][i].z + xv[r][i].w * xv[r][i].w;
      rs[r] = rsqrtf(wave_sum(ss) * (1.f / 1024.f) + EPS);
    }
#pragma unroll
    for (int i = 0; i < 4; ++i) {
      float4 g = *(const float4*)(gh + lane * 4 + 256 * i);
      float4 sh = *(const float4*)(shift + lane * 4 + 256 * i);
      float4 sc = *(const float4*)(scale + lane * 4 + 256 * i);
#pragma unroll
      for (int r = 0; r < NR; ++r) {
        u32x2 u;
        u.x = pack2(xv[r][i].x * rs[r] * g.x * (1.f + sc.x) + sh.x, xv[r][i].y * rs[r] * g.y * (1.f + sc.y) + sh.y);
        u.y = pack2(xv[r][i].z * rs[r] * g.z * (1.f + sc.z) + sh.z, xv[r][i].w * rs[r] * g.w * (1.f + sc.w) + sh.w);
        *(u32x2*)(hrow + r * D + lane * 4 + 256 * i) = u;
      }
    }
  }
}

__device__ __forceinline__ void row_phase(const Params& p, int kind, int l, int nrows) {
  const int wid = otid() >> 6;
  const float* mods = (const float*)(p.ws + OFF_MODS);
  float* Z = (float*)(p.ws + OFF_Z);
  u16* H = (u16*)(p.ws + OFF_HA);
  const u16* O = (const u16*)(p.ws + OFF_O);
  for (int t = blockIdx.x; t < nrows / (4 * NR); t += gridDim.x) {
    {
      int r = t * (4 * NR) + wid * NR;
      int s = r < TX ? (r >> 11) : 16;
      float* res = r < TX ? p.out + (size_t)r * D : Z + (size_t)(r - TX) * D;
      if (kind == 0) {
        const float* src = r < TX ? p.x + (size_t)r * D : p.ctx + (size_t)(r - TX) * D;
        const float* m = mods + ((size_t)0 * 17 + s) * 6144;
        row_pass(src, res, nullptr, nullptr, nullptr, p.norm_g + (0 * 4 + 0) * D, m, m + D, H + (size_t)r * D);
      } else if (kind == 1) {
        const float* m = mods + ((size_t)l * 17 + s) * 6144;
        row_pass(res, res, O + (size_t)r * D, p.norm_g + (l * 4 + 1) * D, m + 2 * D, p.norm_g + (l * 4 + 2) * D,
                 m + 3 * D, m + 4 * D, H + (size_t)r * D);
      } else {
        const float* m = mods + ((size_t)l * 17 + s) * 6144;
        if (l < 3) {
          const float* m2 = mods + ((size_t)(l + 1) * 17 + s) * 6144;
          row_pass(res, res, O + (size_t)r * D, p.norm_g + (l * 4 + 3) * D, m + 5 * D, p.norm_g + ((l + 1) * 4 + 0) * D,
                   m2, m2 + D, H + (size_t)r * D);
        } else {
          row_pass(res, res, O + (size_t)r * D, p.norm_g + (l * 4 + 3) * D, m + 5 * D, nullptr, nullptr, nullptr, nullptr);
        }
      }
    }
  }
}

__device__ __forceinline__ void ffn_conv_phase(const Params& p, int l, int R0, int rows) {
  const u16* U = (const u16*)(p.ws + OFF_U);
  u16* act = (u16*)(p.ws + OFF_ACT);
  const float* cw = p.ffn_conv + (size_t)l * 3 * 2 * DFF;
  const int ntask = rows / 16 * 352 / 256;
  for (int t = blockIdx.x; t < ntask; t += gridDim.x) {
    int item = t * 256 + otid();
    int cg8 = item % 352, rb = item / 352;
    int lr0 = rb * 16, r0 = R0 + lr0;
    int pos0 = r0 < TX ? (r0 & 2047) : ((r0 - TX) & 255);
    int len = r0 < TX ? SEQ : CTX;
    bool pv = pos0 > 0, nv = pos0 + 16 < len;
    float wa[3][8], wg[3][8];
#pragma unroll
    for (int tp = 0; tp < 3; ++tp)
#pragma unroll
      for (int j = 0; j < 8; ++j) { wa[tp][j] = cw[tp * 2 * DFF + cg8 * 8 + j]; wg[tp][j] = cw[tp * 2 * DFF + DFF + cg8 * 8 + j]; }
    const u16* ua = U + (size_t)lr0 * 2 * DFF + cg8 * 8;
    const u16* ug = ua + DFF;
    float am[8], a0[8], ap[8], gm[8], g0[8], gp[8];
    if (pv) { unpack8(*(const u32x4*)(ua - 2 * DFF), am); unpack8(*(const u32x4*)(ug - 2 * DFF), gm); }
    else {
#pragma unroll
      for (int j = 0; j < 8; ++j) { am[j] = 0.f; gm[j] = 0.f; }
    }
    unpack8(*(const u32x4*)(ua), a0); unpack8(*(const u32x4*)(ug), g0);
    for (int k = 0; k < 16; ++k) {
      if (k < 15 || nv) { unpack8(*(const u32x4*)(ua + (size_t)(k + 1) * 2 * DFF), ap); unpack8(*(const u32x4*)(ug + (size_t)(k + 1) * 2 * DFF), gp); }
      else {
#pragma unroll
        for (int j = 0; j < 8; ++j) { ap[j] = 0.f; gp[j] = 0.f; }
      }
      float o[8];
#pragma unroll
      for (int j = 0; j < 8; ++j) {
        float ca = wa[0][j] * am[j] + wa[1][j] * a0[j] + wa[2][j] * ap[j];
        float cgv = wg[0][j] * gm[j] + wg[1][j] * g0[j] + wg[2][j] * gp[j];
        o[j] = siluf(cgv) * ca;
        am[j] = a0[j]; a0[j] = ap[j]; gm[j] = g0[j]; g0[j] = gp[j];
      }
      *(u32x4*)(act + (size_t)(r0 + k) * DFF + cg8 * 8) = pack8(o);
    }
  }
}

__device__ __forceinline__ void tr128(const u16* __restrict__ src, size_t sld, u16* __restrict__ dst, size_t dld, char* smem) {
  u16* tile = (u16*)smem;
  const int tid = otid(), a = tid >> 2, b16 = (tid & 3) * 16;
  __syncthreads();
  {
    const u16* sp0 = src + (size_t)a * sld + b16;
    const u16* sp1 = src + (size_t)(a + 64) * sld + b16;
    u32x4 v0 = *(const u32x4*)sp0, v1 = *(const u32x4*)(sp0 + 8), v2 = *(const u32x4*)sp1, v3 = *(const u32x4*)(sp1 + 8);
    const u16* e0 = (const u16*)&v0;
    const u16* e1 = (const u16*)&v1;
    const u16* e2 = (const u16*)&v2;
    const u16* e3 = (const u16*)&v3;
#pragma unroll
    for (int j = 0; j < 8; ++j) {
      tile[(b16 + j) * 136 + a] = e0[j]; tile[(b16 + 8 + j) * 136 + a] = e1[j];
      tile[(b16 + j) * 136 + a + 64] = e2[j]; tile[(b16 + 8 + j) * 136 + a + 64] = e3[j];
    }
  }
  __syncthreads();
  {
    const u16* tp = tile + a * 136 + 32 * (tid & 3);
    u16* dp = dst + (size_t)a * dld + 32 * (tid & 3);
#pragma unroll
    for (int k = 0; k < 4; ++k) *(u32x4*)(dp + 8 * k) = *(const u32x4*)(tp + 8 * k);
  }
}

__device__ __forceinline__ void rope_task(const Params& p, u16* P, int ldp, int col0, int nhb, int t) {
  const int tid = otid();
  u32x4 v1[4], v2[4];
#pragma unroll
  for (int k = 0; k < 4; ++k) {
    const int idx = (t * 4 + k) * 256 + tid;
    const int grp = idx & 1, part = (idx >> 1) & 1, rest = idx >> 2;
    const int hb = rest % nhb, r = rest / nhb;
    const u16* base = P + (size_t)r * ldp + col0 + hb * 64 + part * 32 + grp * 8;
    v1[k] = *(const u32x4*)base; v2[k] = *(const u32x4*)(base + 16);
  }
#pragma unroll
  for (int k = 0; k < 4; ++k) {
    const int idx = (t * 4 + k) * 256 + tid;
    const int grp = idx & 1, part = (idx >> 1) & 1, rest = idx >> 2;
    const int hb = rest % nhb, r = rest / nhb;
    const int pos = r & 2047;
    u16* base = P + (size_t)r * ldp + col0 + hb * 64 + part * 32 + grp * 8;
    float x1[8], x2[8], o1[8], o2[8];
    unpack8(v1[k], x1); unpack8(v2[k], x2);
    const float2* cs = (const float2*)(p.ws + OFF_ROPE) + pos * 32 + part * 16 + grp * 8;
#pragma unroll
    for (int j = 0; j < 8; ++j) {
      float2 c = cs[j];
      o1[j] = x1[j] * c.x - x2[j] * c.y;
      o2[j] = x2[j] * c.x + x1[j] * c.y;
    }
    *(u32x4*)base = pack8(o1);
    *(u32x4*)(base + 16) = pack8(o2);
  }
}

__device__ __forceinline__ void ut_task(const Params& p, int i, int rtp, int ct, char* smem) {
  u16* tile = (u16*)smem;
  const u16* P = (const u16*)(p.ws + OFF_BIG);
  u16* UT = (u16*)(p.ws + OFF_UT);
  const int tid = otid(), a = tid >> 2, b16 = (tid & 3) * 16;
  const int cc0 = ct * 64 + b16;
  const float* cw = p.hy_conv + (size_t)i * 3 * 1536 + cc0;
  float w[3][16];
#pragma unroll
  for (int tp = 0; tp < 3; ++tp)
#pragma unroll
    for (int q = 0; q < 4; ++q) {
      float4 wv = *(const float4*)(cw + tp * 1536 + 4 * q);
      w[tp][4 * q] = wv.x; w[tp][4 * q + 1] = wv.y; w[tp][4 * q + 2] = wv.z; w[tp][4 * q + 3] = wv.w;
    }
  u32x4 v[2][3][2];
  bool ok[2][3];
#pragma unroll
  for (int h = 0; h < 2; ++h) {
    const int r = rtp * 128 + h * 64 + a;
    const int pos = r < TX ? (r & 2047) : ((r - TX) & 255);
    const int len = r < TX ? SEQ : CTX;
#pragma unroll
    for (int tp = 0; tp < 3; ++tp) {
      const int pp = pos + tp - 1;
      ok[h][tp] = pp >= 0 && pp < len;
      const u16* sp = P + (size_t)(ok[h][tp] ? r + tp - 1 : r) * PCD + 768 + cc0;
      v[h][tp][0] = *(const u32x4*)sp; v[h][tp][1] = *(const u32x4*)(sp + 8);
    }
  }
  __syncthreads();
#pragma unroll
  for (int h = 0; h < 2; ++h) {
    float acc[16];
#pragma unroll
    for (int j = 0; j < 16; ++j) acc[j] = 0.f;
#pragma unroll
    for (int tp = 0; tp < 3; ++tp) {
      float f[16];
      unpack8(v[h][tp][0], f); unpack8(v[h][tp][1], f + 8);
#pragma unroll
      for (int j = 0; j < 16; ++j) acc[j] += ok[h][tp] ? w[tp][j] * f[j] : 0.f;
    }
#pragma unroll
    for (int j = 0; j < 16; ++j) tile[(b16 + j) * 136 + a + 64 * h] = f2bf(acc[j]);
  }
  __syncthreads();
  {
    const u16* tp = tile + a * 136 + 32 * (tid & 3);
    u16* dp = UT + (size_t)(ct * 64 + a) * TT + rtp * 128 + 32 * (tid & 3);
#pragma unroll
    for (int k = 0; k < 4; ++k) *(u32x4*)(dp + 8 * k) = *(const u32x4*)(tp + 8 * k);
  }
}

template <int E, bool MASK>
__device__ __forceinline__ void flash_pass(const u16* __restrict__ P, int ldp, int qrow0, int qcol, int kcol, int xrow0, int zrow0,
                                           const u16* __restrict__ Vt, int t0lo, int t0hi, int qpos0, float m_init, float l_init,
                                           f32x4 (&o)[2][E / 16], char* smem) {
  const int tid = otid(), lane = tid & 63, l15 = lane & 15, quad = lane >> 4;
  u16* Ks = (u16*)smem;
  u16* Vs = Ks + 64 * 72;
  bf16x8 qf[2][2];
#pragma unroll
  for (int qt = 0; qt < 2; ++qt)
#pragma unroll
    for (int ks = 0; ks < 2; ++ks) {
      u32x4 v = *(const u32x4*)(P + (size_t)(qrow0 + 16 * qt + l15) * ldp + qcol + 32 * ks + 8 * quad);
      float f[8];
      unpack8(v, f);
#pragma unroll
      for (int j = 0; j < 8; ++j) f[j] *= 0.125f;
      qf[qt][ks] = as_bf8(pack8(f));
    }
  float m[2] = {m_init, m_init}, l[2] = {l_init, l_init};
#pragma unroll
  for (int qt = 0; qt < 2; ++qt)
#pragma unroll
    for (int et = 0; et < E / 16; ++et) o[qt][et] = f32x4{0.f, 0.f, 0.f, 0.f};
  const int ntx = t0hi - t0lo, ntiles = ntx + 4;
  u32x4 kr[2], vr[E / 32];
  auto gload = [&](int it) {
    int kt = it < ntx ? t0lo + it : 32 + (it - ntx);
    int rbase = kt < 32 ? xrow0 + kt * 64 : zrow0 + (kt - 32) * 64;
#pragma unroll
    for (int i = 0; i < 2; ++i) {
      int idx = tid + 256 * i, key = idx >> 3, c8 = idx & 7;
      kr[i] = *(const u32x4*)(P + (size_t)(rbase + key) * ldp + kcol + c8 * 8);
    }
#pragma unroll
    for (int i = 0; i < E / 32; ++i) {
      int idx = tid + 256 * i, e = idx >> 3, c8 = idx & 7;
      vr[i] = *(const u32x4*)(Vt + (size_t)e * NKEY + kt * 64 + c8 * 8);
    }
  };
  gload(0);
  for (int it = 0; it < ntiles; ++it) {
    __syncthreads();
#pragma unroll
    for (int i = 0; i < 2; ++i) {
      int idx = tid + 256 * i, key = idx >> 3, c8 = idx & 7;
      *(u32x4*)(Ks + key * 72 + c8 * 8) = kr[i];
    }
#pragma unroll
    for (int i = 0; i < E / 32; ++i) {
      int idx = tid + 256 * i, e = idx >> 3, c8 = idx & 7;
      *(u32x4*)(Vs + e * 72 + c8 * 8) = vr[i];
    }
    __syncthreads();
    if (it + 1 < ntiles) gload(it + 1);
    f32x4 s[4][2];
#pragma unroll
    for (int k4 = 0; k4 < 4; ++k4) {
      s[k4][0] = f32x4{0.f, 0.f, 0.f, 0.f};
      s[k4][1] = f32x4{0.f, 0.f, 0.f, 0.f};
#pragma unroll
      for (int ks = 0; ks < 2; ++ks) {
        bf16x8 a = *(const bf16x8*)(Ks + (16 * k4 + l15) * 72 + 32 * ks + 8 * quad);
        s[k4][0] = MFMA(a, qf[0][ks], s[k4][0]);
        s[k4][1] = MFMA(a, qf[1][ks], s[k4][1]);
      }
    }
    if (MASK && it < ntx) {
      int kbase = (t0lo + it) * 64 + 4 * quad;
#pragma unroll
      for (int k4 = 0; k4 < 4; ++k4)
#pragma unroll
        for (int qt = 0; qt < 2; ++qt)
#pragma unroll
          for (int j = 0; j < 4; ++j) {
            int dlt = (qpos0 + 16 * qt + l15) - (kbase + 16 * k4 + j);
            if (dlt > 128 || dlt < -128) s[k4][qt][j] = -1e30f;
          }
    }
#pragma unroll
    for (int qt = 0; qt < 2; ++qt) {
      float mx = -1e30f;
#pragma unroll
      for (int k4 = 0; k4 < 4; ++k4)
#pragma unroll
        for (int j = 0; j < 4; ++j) mx = fmaxf(mx, s[k4][qt][j]);
      mx = fmaxf(mx, __shfl_xor(mx, 16));
      mx = fmaxf(mx, __shfl_xor(mx, 32));
      const float L2E = 1.4426950408889634f;
      float mn = fmaxf(m[qt], mx);
      float alpha = __builtin_amdgcn_exp2f((m[qt] - mn) * L2E);
      m[qt] = mn;
      const float mn2 = -mn * L2E;
      float sum = 0.f;
#pragma unroll
      for (int k4 = 0; k4 < 4; ++k4)
#pragma unroll
        for (int j = 0; j < 4; ++j) {
          float pv = __builtin_amdgcn_exp2f(fmaf(s[k4][qt][j], L2E, mn2));
          s[k4][qt][j] = pv;
          sum += pv;
        }
      sum += __shfl_xor(sum, 16);
      sum += __shfl_xor(sum, 32);
      l[qt] = l[qt] * alpha + sum;
      if (__any(alpha != 1.f)) {
#pragma unroll
        for (int j = 0; j < 4; ++j) {
          float aj = __shfl(alpha, 4 * quad + j);
#pragma unroll
          for (int et = 0; et < E / 16; ++et) o[qt][et][j] *= aj;
        }
      }
    }
#pragma unroll
    for (int kg = 0; kg < 2; ++kg) {
      bf16x8 pf[2];
#pragma unroll
      for (int qt = 0; qt < 2; ++qt) {
        u32x4 u;
        u.x = pack2(s[2 * kg][qt][0], s[2 * kg][qt][1]);
        u.y = pack2(s[2 * kg][qt][2], s[2 * kg][qt][3]);
        u.z = pack2(s[2 * kg + 1][qt][0], s[2 * kg + 1][qt][1]);
        u.w = pack2(s[2 * kg + 1][qt][2], s[2 * kg + 1][qt][3]);
        pf[qt] = as_bf8(u);
      }
#pragma unroll
      for (int et = 0; et < E / 16; ++et) {
        const u16* vp = Vs + (16 * et + l15) * 72 + 32 * kg + 4 * quad;
        u32x2 b0 = *(const u32x2*)vp, b1 = *(const u32x2*)(vp + 16);
        bf16x8 bv = as_bf8(mk4(b0.x, b0.y, b1.x, b1.y));
        o[0][et] = MFMA(pf[0], bv, o[0][et]);
        o[1][et] = MFMA(pf[1], bv, o[1][et]);
      }
    }
  }
#pragma unroll
  for (int qt = 0; qt < 2; ++qt) {
    float inv = 1.f / l[qt];
#pragma unroll
    for (int j = 0; j < 4; ++j) {
      float ij = __shfl(inv, 4 * quad + j);
#pragma unroll
      for (int et = 0; et < E / 16; ++et) o[qt][et][j] *= ij;
    }
  }
}

__device__ __forceinline__ void diff_task(const Params& p, int li, int task, char* smem) {
  const int qb = task % 18, h = (task / 18) & 3, b = task / 72;
  const int tid = otid(), lane = tid & 63, wid = tid >> 6, l15 = lane & 15, quad = lane >> 4;
  const u16* P = (const u16*)(p.ws + OFF_BIG);
  const u16* Vt = (const u16*)(p.ws + OFF_VTD) + (size_t)((b * 4 + h) * 128) * NKEY;
  u16* Aout = (u16*)(p.ws + OFF_HA);
  const bool isx = qb < 16;
  const int qrow0 = (isx ? b * SEQ + qb * 128 : TX + b * CTX + (qb - 16) * 128) + 32 * wid;
  const float lam = ((const float*)(p.ws + OFF_LAM))[li];
  const float lam_init = ((const float*)(p.ws + OFF_LAM))[2 + li];
  unsigned* o0s = (unsigned*)(smem + 27648) + wid * 32 * 64 + lane;
  f32x4 o[2][8];
#pragma unroll 1
  for (int t = 0; t < 2; ++t) {
    flash_pass<128, false>(P, PAB, qrow0, 2080 + h * 128 + t * 64, 2592 + h * 128 + t * 64, b * SEQ, TX + b * CTX, Vt,
                           0, isx ? 32 : 0, 0, -1e30f, 0.f, o, smem);
    if (t == 0) {
#pragma unroll
      for (int qt = 0; qt < 2; ++qt)
#pragma unroll
        for (int et = 0; et < 8; ++et) {
          o0s[((qt * 8 + et) * 2 + 0) * 64] = pack2(o[qt][et][0], o[qt][et][1]);
          o0s[((qt * 8 + et) * 2 + 1) * 64] = pack2(o[qt][et][2], o[qt][et][3]);
        }
    }
  }
  const float* g = p.diff_norm_g + li * 128;
#pragma unroll
  for (int qt = 0; qt < 2; ++qt) {
    float ss[4] = {0.f, 0.f, 0.f, 0.f};
#pragma unroll
    for (int et = 0; et < 8; ++et) {
      unsigned w0 = o0s[((qt * 8 + et) * 2 + 0) * 64], w1 = o0s[((qt * 8 + et) * 2 + 1) * 64];
      float a0 = lo2f(w0), a1 = hi2f(w0), a2 = lo2f(w1), a3 = hi2f(w1);
      o[qt][et][0] = a0 - lam * o[qt][et][0];
      o[qt][et][1] = a1 - lam * o[qt][et][1];
      o[qt][et][2] = a2 - lam * o[qt][et][2];
      o[qt][et][3] = a3 - lam * o[qt][et][3];
#pragma unroll
      for (int j = 0; j < 4; ++j) ss[j] += o[qt][et][j] * o[qt][et][j];
    }
#pragma unroll
    for (int j = 0; j < 4; ++j) {
      float v = ss[j];
      v += __shfl_xor(v, 1); v += __shfl_xor(v, 2); v += __shfl_xor(v, 4); v += __shfl_xor(v, 8);
      float rs = rsqrtf(v * (1.f / 128.f) + EPS) * (1.f - lam_init);
      int row = qrow0 + 16 * qt + 4 * quad + j;
#pragma unroll
      for (int et = 0; et < 8; ++et) {
        int e = 16 * et + l15;
        Aout[(size_t)row * D + 512 + h * 128 + e] = f2bf(o[qt][et][j] * rs * g[e]);
      }
    }
  }
}

__device__ __forceinline__ void swa_task(const Params& p, int i, int task, char* smem) {
  const int qb = task % 18, hq = (task / 18) & 7, b = task / 144;
  const int tid = otid(), lane = tid & 63, wid = tid >> 6, l15 = lane & 15, quad = lane >> 4;
  const u16* P = (const u16*)(p.ws + OFF_BIG);
  const int kv = hq >> 2;
  const u16* Vt = (const u16*)(p.ws + OFF_VTS) + (size_t)((b * 2 + kv) * 64) * NKEY;
  u16* Aout = (u16*)(p.ws + OFF_HA);
  const bool isx = qb < 16;
  const int qrow0 = (isx ? b * SEQ + qb * 128 : TX + b * CTX + (qb - 16) * 128) + 32 * wid;
  const float sink = p.swa_sink[i * 8 + hq];
  int lo = 0, hi = 0;
  if (isx) { lo = qb * 2 - 2; if (lo < 0) lo = 0; hi = qb * 2 + 4; if (hi > 32) hi = 32; }
  f32x4 o[2][4];
  flash_pass<64, true>(P, PCD, qrow0, hq * 64, 512 + kv * 64, b * SEQ, TX + b * CTX, Vt, lo, hi, qb * 128 + 32 * wid, sink, 1.f, o, smem);
#pragma unroll
  for (int qt = 0; qt < 2; ++qt)
#pragma unroll
    for (int j = 0; j < 4; ++j) {
      int row = qrow0 + 16 * qt + 4 * quad + j;
#pragma unroll
      for (int et = 0; et < 4; ++et) Aout[(size_t)row * D + hq * 64 + 16 * et + l15] = f2bf(o[qt][et][j]);
    }
}

constexpr size_t OFF_HALO = OFF_XBAR + 16384;
static_assert(OFF_HALO + (size_t)576 * 2 * 1536 * 2 <= (size_t)512 * 1024 * 1024, "ws");

__device__ __forceinline__ void halo_task(const Params& p, int ch) {
  const int tid = otid();
  if (tid >= 192) return;
  const u16* P = (const u16*)(p.ws + OFF_BIG);
  u16* HB = (u16*)(p.ws + OFF_HALO) + (size_t)ch * 2 * 1536;
  const int r0 = ch * 64;
  const int pos0 = r0 < TX ? (r0 & 2047) : ((r0 - TX) & 255);
  const int len = r0 < TX ? SEQ : CTX;
  u32x4 z = mk4(0, 0, 0, 0);
  u32x4 a = pos0 > 0 ? *(const u32x4*)(P + (size_t)(r0 - 1) * PAB + tid * 8) : z;
  u32x4 b = pos0 + 64 < len ? *(const u32x4*)(P + (size_t)(r0 + 64) * PAB + tid * 8) : z;
  *(u32x4*)(HB + tid * 8) = a;
  *(u32x4*)(HB + 1536 + tid * 8) = b;
}

__device__ __forceinline__ void qkvconv_task(const Params& p, int li, int t) {
  const int ch = t >> 3, h = t & 7;
  const int tid = otid(), i = tid >> 2, dd = (tid & 3) * 16;
  u16* P = (u16*)(p.ws + OFF_BIG);
  const u16* HB = (const u16*)(p.ws + OFF_HALO) + (size_t)ch * 2 * 1536;
  const float* cw = p.gdn_conv + (size_t)li * 3 * 1536;
  const int r = ch * 64 + i;
  float qv[16], kv[16], vv[16];
#pragma unroll
  for (int j = 0; j < 16; ++j) { qv[j] = 0.f; kv[j] = 0.f; vv[j] = 0.f; }
#pragma unroll
  for (int tp = 0; tp < 3; ++tp) {
    const u16* rp;
    if (tp == 0) rp = (i > 0) ? P + (size_t)(r - 1) * PAB : HB;
    else if (tp == 1) rp = P + (size_t)r * PAB;
    else rp = (i < 63) ? P + (size_t)(r + 1) * PAB : HB + 1536;
    rp += h * 64 + dd;
    const float* wq = cw + tp * 1536 + h * 64 + dd;
    float f[16];
    unpack8(*(const u32x4*)rp, f); unpack8(*(const u32x4*)(rp + 8), f + 8);
#pragma unroll
    for (int j = 0; j < 16; ++j) qv[j] += wq[j] * f[j];
    unpack8(*(const u32x4*)(rp + 512), f); unpack8(*(const u32x4*)(rp + 520), f + 8);
#pragma unroll
    for (int j = 0; j < 16; ++j) kv[j] += wq[512 + j] * f[j];
    unpack8(*(const u32x4*)(rp + 1024), f); unpack8(*(const u32x4*)(rp + 1032), f + 8);
#pragma unroll
    for (int j = 0; j < 16; ++j) vv[j] += wq[1024 + j] * f[j];
  }
  float sq = 0.f, sk = 0.f;
#pragma unroll
  for (int j = 0; j < 16; ++j) {
    qv[j] = silu_fast(qv[j]); kv[j] = silu_fast(kv[j]); vv[j] = silu_fast(vv[j]);
    sq += qv[j] * qv[j]; sk += kv[j] * kv[j];
  }
  sq += __shfl_xor(sq, 1); sq += __shfl_xor(sq, 2);
  sk += __shfl_xor(sk, 1); sk += __shfl_xor(sk, 2);
  float rq = rsqrtf(sq + EPS) * 0.125f, rk = rsqrtf(sk + EPS);
#pragma unroll
  for (int j = 0; j < 16; ++j) { qv[j] *= rq; kv[j] *= rk; }
  u32x4 o0 = pack8(qv), o1 = pack8(qv + 8), o2 = pack8(kv), o3 = pack8(kv + 8), o4 = pack8(vv), o5 = pack8(vv + 8);
  __syncthreads();
  u16* wp = P + (size_t)r * PAB + h * 64 + dd;
  *(u32x4*)wp = o0; *(u32x4*)(wp + 8) = o1;
  *(u32x4*)(wp + 512) = o2; *(u32x4*)(wp + 520) = o3;
  *(u32x4*)(wp + 1024) = o4; *(u32x4*)(wp + 1032) = o5;
}

#define MFMA32(a, b, c) __builtin_amdgcn_mfma_f32_16x16x4f32(a, b, c, 0, 0, 0)
__device__ __forceinline__ void gdn_chain(const Params& p, int li, int task, char* smem) {
  const int b = task >> 4, h = (task >> 1) & 7, dir = task & 1;
  u16* qs = (u16*)smem;
  u16* ks = qs + 4608;
  u16* vs = ks + 4608;
  float* Af = (float*)(vs + 4608);
  u16* vnT = (u16*)Af;
  u16* qkb = (u16*)(Af + 4096);
  u16* ktT = qkb + 4608;
  u16* Sb = ktT + 4608;
  float* sm = (float*)(Sb + 4608);
  u16* wb = ks;
  u16* ubT = vs;
  const u16* P = (const u16*)(p.ws + OFF_BIG);
  u16* Od = (u16*)(p.ws + OFF_O) + (size_t)dir * TT * 512;
  const float a_neg = -expf(p.gdn_a_log[li * 16 + dir * 8 + h]);
  const float dtb = p.gdn_dt_bias[li * 16 + dir * 8 + h];
  f32x4 S[4];
#pragma unroll
  for (int et = 0; et < 4; ++et) S[et] = f32x4{0.f, 0.f, 0.f, 0.f};
  __syncthreads();
  for (int i = otid(); i < 4608; i += 256) Sb[i] = 0;
  u32x4 pq0, pq1, pk0, pk1, pv0, pv1;
  float ppb = 0.f, ppa = 0.f;
  {
    const int tid = otid(), i = tid >> 2, dd = (tid & 3) * 16, lane = tid & 63;
    const int pos = dir ? (CTX - 1 - i) : i;
    const u16* rp = P + (size_t)(TX + b * CTX + pos) * PAB + h * 64 + dd;
    pq0 = *(const u32x4*)rp; pq1 = *(const u32x4*)(rp + 8);
    pk0 = *(const u32x4*)(rp + 512); pk1 = *(const u32x4*)(rp + 520);
    pv0 = *(const u32x4*)(rp + 1024); pv1 = *(const u32x4*)(rp + 1032);
    if (tid < 64) {
      const int pos2 = dir ? (CTX - 1 - lane) : lane;
      const u16* gp = P + (size_t)(TX + b * CTX + pos2) * PAB;
      ppb = bf2f(gp[2048 + dir * 8 + h]); ppa = bf2f(gp[2064 + dir * 8 + h]);
    }
  }
  __builtin_amdgcn_s_setprio(2);
  for (int n = 0; n < 36; ++n) {
    const int tid = otid(), lane = tid & 63, wid = tid >> 6, l15 = lane & 15, quad = lane >> 4;
    const int rowbase = n < 4 ? TX + b * CTX : b * SEQ;
    const int L = n < 4 ? CTX : SEQ;
    const int cn = n < 4 ? n : n - 4;
    {
      const int i = tid >> 2, dd = (tid & 3) * 16;
      *(u32x4*)(qs + i * 72 + dd) = pq0; *(u32x4*)(qs + i * 72 + dd + 8) = pq1;
      *(u32x4*)(ks + i * 72 + dd) = pk0; *(u32x4*)(ks + i * 72 + dd + 8) = pk1;
      *(u32x4*)(vs + i * 72 + dd) = pv0; *(u32x4*)(vs + i * 72 + dd + 8) = pv1;
      if (wid == 0) {
        float beta = 1.f / (1.f + expf(-ppb));
        float xa = ppa + dtb;
        float sp = xa > 20.f ? xa : log1pf(expf(xa));
        float g = a_neg * sp;
        float gcs = g;
#pragma unroll
        for (int o = 1; o < 64; o <<= 1) {
          float t = __shfl_up(gcs, o);
          if (lane >= o) gcs += t;
        }
        float gl = __shfl(gcs, 63);
        sm[lane] = gcs; sm[64 + lane] = beta; sm[128 + lane] = expf(gcs); sm[192 + lane] = expf(gl - gcs);
      }
      if (n + 1 < 36) {
        const int n1 = n + 1;
        const int rb1 = n1 < 4 ? TX + b * CTX : b * SEQ, L1 = n1 < 4 ? CTX : SEQ, cn1 = n1 < 4 ? n1 : n1 - 4;
        const int sidx = cn1 * 64 + i;
        const int pos = dir ? (L1 - 1 - sidx) : sidx;
        const u16* rp = P + (size_t)(rb1 + pos) * PAB + h * 64 + dd;
        pq0 = *(const u32x4*)rp; pq1 = *(const u32x4*)(rp + 8);
        pk0 = *(const u32x4*)(rp + 512); pk1 = *(const u32x4*)(rp + 520);
        pv0 = *(const u32x4*)(rp + 1024); pv1 = *(const u32x4*)(rp + 1032);
        if (wid == 0) {
          const int sidx2 = cn1 * 64 + lane;
          const int pos2 = dir ? (L1 - 1 - sidx2) : sidx2;
          const u16* gp = P + (size_t)(rb1 + pos2) * PAB;
          ppb = bf2f(gp[2048 + dir * 8 + h]); ppa = bf2f(gp[2064 + dir * 8 + h]);
        }
      }
    }
    __syncthreads();
    {
      bf16x8 ka[2], qa[2];
#pragma unroll
      for (int s2 = 0; s2 < 2; ++s2) {
        ka[s2] = *(const bf16x8*)(ks + (16 * wid + l15) * 72 + 32 * s2 + 8 * quad);
        qa[s2] = *(const bf16x8*)(qs + (16 * wid + l15) * 72 + 32 * s2 + 8 * quad);
      }
#pragma unroll
      for (int jt = 0; jt < 4; ++jt) {
        f32x4 kk = f32x4{0.f, 0.f, 0.f, 0.f}, qq = f32x4{0.f, 0.f, 0.f, 0.f};
        if (jt <= wid) {
#pragma unroll
          for (int s2 = 0; s2 < 2; ++s2) {
            bf16x8 kb = *(const bf16x8*)(ks + (16 * jt + l15) * 72 + 32 * s2 + 8 * quad);
            kk = MFMA(ka[s2], kb, kk);
            qq = MFMA(qa[s2], kb, qq);
          }
        }
        const int jj = 16 * jt + l15;
        const float gj = sm[jj];
#pragma unroll
        for (int j = 0; j < 4; ++j) {
          const int ii = 16 * wid + 4 * quad + j;
          float dg = sm[ii] - gj;
          float dec = __builtin_amdgcn_exp2f(1.4426950408889634f * fminf(dg, 0.f));
          Af[ii * 64 + jj] = (ii > jj) ? kk[j] * sm[64 + ii] * dec : 0.f;
          qkb[ii * 72 + jj] = f2bf((ii >= jj) ? qq[j] * dec : 0.f);
        }
      }
    }
    __syncthreads();
    f32x4 R[2][4];
    {
      const int c0 = 32 * (wid & 1) + l15;
#pragma unroll
      for (int ct = 0; ct < 2; ++ct)
#pragma unroll
        for (int I = 0; I < 4; ++I)
#pragma unroll
          for (int j = 0; j < 4; ++j) {
            const int row = 16 * I + 4 * quad + j;
            const float bt = sm[64 + row];
            R[ct][I][j] = (wid < 2) ? bf2f(vs[row * 72 + c0 + 16 * ct]) * bt : bf2f(ks[row * 72 + c0 + 16 * ct]) * bt * sm[128 + row];
          }
    }
    if (wid == 0) {
      const int blk = quad, col = l15;
      const float* ab = Af + (16 * blk) * 64 + 16 * blk;
      float t[16];
#pragma unroll
      for (int i = 0; i < 16; ++i) t[i] = (i == col) ? 1.f : 0.f;
#pragma unroll
      for (int i = 1; i < 16; ++i) {
        float sacc = 0.f;
#pragma unroll
        for (int j4 = 0; j4 < (i + 3) / 4; ++j4) {
          float4 a = *(const float4*)(ab + i * 64 + 4 * j4);
          if (4 * j4 + 0 < i) sacc += a.x * t[4 * j4 + 0];
          if (4 * j4 + 1 < i) sacc += a.y * t[4 * j4 + 1];
          if (4 * j4 + 2 < i) sacc += a.z * t[4 * j4 + 2];
          if (4 * j4 + 3 < i) sacc += a.w * t[4 * j4 + 3];
        }
        t[i] = (i > col) ? -sacc : t[i];
      }
      float* tb = Af + (16 * blk) * 64 + 16 * blk + col;
#pragma unroll
      for (int i = 0; i < 16; ++i) tb[i * 64] = t[i];
    } else if (wid >= 2) {
      const int tt = tid - 128, i = tt >> 1, d0 = (tt & 1) * 32;
      const float eg = sm[128 + i], etl = sm[192 + i];
#pragma unroll
      for (int q4 = 0; q4 < 4; ++q4) {
        float f[8];
        unpack8(*(const u32x4*)(qs + i * 72 + d0 + q4 * 8), f);
#pragma unroll
        for (int j = 0; j < 8; ++j) f[j] *= eg;
        *(u32x4*)(qs + i * 72 + d0 + q4 * 8) = pack8(f);
        unpack8(*(const u32x4*)(ks + i * 72 + d0 + q4 * 8), f);
#pragma unroll
        for (int j = 0; j < 8; ++j) ktT[(d0 + q4 * 8 + j) * 72 + i] = f2bf(f[j] * etl);
      }
    }
    const float egl = sm[128 + 63];
    __syncthreads();
    {
      f32x4 X[2][4];
#pragma unroll
      for (int I = 0; I < 4; ++I) {
        f32x4 y0 = R[0][I], y1 = R[1][I];
#pragma unroll
        for (int J = 0; J < I; ++J) {
          float4 av = *(const float4*)(Af + (16 * I + l15) * 64 + 16 * J + 4 * quad);
          y0 = MFMA32(-av.x, X[0][J][0], y0); y1 = MFMA32(-av.x, X[1][J][0], y1);
          y0 = MFMA32(-av.y, X[0][J][1], y0); y1 = MFMA32(-av.y, X[1][J][1], y1);
          y0 = MFMA32(-av.z, X[0][J][2], y0); y1 = MFMA32(-av.z, X[1][J][2], y1);
          y0 = MFMA32(-av.w, X[0][J][3], y0); y1 = MFMA32(-av.w, X[1][J][3], y1);
        }
        float4 tv = *(const float4*)(Af + (16 * I + l15) * 64 + 16 * I + 4 * quad);
        f32x4 x0 = f32x4{0.f, 0.f, 0.f, 0.f}, x1 = f32x4{0.f, 0.f, 0.f, 0.f};
        x0 = MFMA32(tv.x, y0[0], x0); x1 = MFMA32(tv.x, y1[0], x1);
        x0 = MFMA32(tv.y, y0[1], x0); x1 = MFMA32(tv.y, y1[1], x1);
        x0 = MFMA32(tv.z, y0[2], x0); x1 = MFMA32(tv.z, y1[2], x1);
        x0 = MFMA32(tv.w, y0[3], x0); x1 = MFMA32(tv.w, y1[3], x1);
        X[0][I] = x0; X[1][I] = x1;
      }
      const int c0 = 32 * (wid & 1) + l15;
#pragma unroll
      for (int ct = 0; ct < 2; ++ct)
#pragma unroll
        for (int I = 0; I < 4; ++I) {
          if (wid < 2) {
            u32x2 uu;
            uu.x = pack2(X[ct][I][0], X[ct][I][1]); uu.y = pack2(X[ct][I][2], X[ct][I][3]);
            *(u32x2*)(ubT + (c0 + 16 * ct) * 72 + 16 * I + 4 * quad) = uu;
          } else {
#pragma unroll
            for (int j = 0; j < 4; ++j) wb[(16 * I + 4 * quad + j) * 72 + c0 + 16 * ct] = f2bf(X[ct][I][j]);
          }
        }
    }
    __syncthreads();
    f32x4 oacc[4];
    {
      bf16x8 wa[2], qa[2];
#pragma unroll
      for (int s2 = 0; s2 < 2; ++s2) {
        wa[s2] = *(const bf16x8*)(wb + (16 * wid + l15) * 72 + 32 * s2 + 8 * quad);
        qa[s2] = *(const bf16x8*)(qs + (16 * wid + l15) * 72 + 32 * s2 + 8 * quad);
      }
#pragma unroll
      for (int et = 0; et < 4; ++et) {
        f32x4 t1 = f32x4{0.f, 0.f, 0.f, 0.f};
        oacc[et] = f32x4{0.f, 0.f, 0.f, 0.f};
#pragma unroll
        for (int s2 = 0; s2 < 2; ++s2) {
          bf16x8 sb = *(const bf16x8*)(Sb + (16 * et + l15) * 72 + 32 * s2 + 8 * quad);
          t1 = MFMA(wa[s2], sb, t1);
          oacc[et] = MFMA(qa[s2], sb, oacc[et]);
        }
        u32x2 uu = *(const u32x2*)(ubT + (16 * et + l15) * 72 + 16 * wid + 4 * quad);
        u32x2 vn;
        vn.x = pack2(lo2f(uu.x) - t1[0], hi2f(uu.x) - t1[1]);
        vn.y = pack2(lo2f(uu.y) - t1[2], hi2f(uu.y) - t1[3]);
        *(u32x2*)(vnT + (16 * et + l15) * 72 + 16 * wid + 4 * quad) = vn;
      }
    }
    __syncthreads();
    {
      bf16x8 qa[2], ka[2];
#pragma unroll
      for (int s2 = 0; s2 < 2; ++s2) {
        qa[s2] = *(const bf16x8*)(qkb + (16 * wid + l15) * 72 + 32 * s2 + 8 * quad);
        ka[s2] = *(const bf16x8*)(ktT + (16 * wid + l15) * 72 + 32 * s2 + 8 * quad);
      }
#pragma unroll
      for (int et = 0; et < 4; ++et) {
        f32x4 sn = S[et] * egl;
#pragma unroll
        for (int s2 = 0; s2 < 2; ++s2) {
          bf16x8 vb = *(const bf16x8*)(vnT + (16 * et + l15) * 72 + 32 * s2 + 8 * quad);
          oacc[et] = MFMA(qa[s2], vb, oacc[et]);
          sn = MFMA(ka[s2], vb, sn);
        }
        S[et] = sn;
        u32x2 sp;
        sp.x = pack2(sn[0], sn[1]); sp.y = pack2(sn[2], sn[3]);
        *(u32x2*)(Sb + (16 * et + l15) * 72 + 16 * wid + 4 * quad) = sp;
#pragma unroll
        for (int j = 0; j < 4; ++j) {
          const int sidx = cn * 64 + 16 * wid + 4 * quad + j;
          const int pos = dir ? (L - 1 - sidx) : sidx;
          Od[(size_t)(rowbase + pos) * 512 + h * 64 + 16 * et + l15] = f2bf(oacc[et][j]);
        }
      }
    }
  }
  __builtin_amdgcn_s_setprio(0);
  __syncthreads();
}

__device__ __forceinline__ void gdn_out_task(const Params& p, int li, int t) {
  const int tid = otid();
  const u16* OF = (const u16*)(p.ws + OFF_O);
  const u16* OB = OF + (size_t)TT * 512;
  const u16* P = (const u16*)(p.ws + OFF_BIG);
  u16* Aout = (u16*)(p.ws + OFF_HA);
  u32x4 va[4], vb[4], vg[4];
#pragma unroll
  for (int k = 0; k < 4; ++k) {
    const int idx = (t * 4 + k) * 256 + tid;
    const int r = idx >> 6, h = (idx >> 3) & 7, g8 = idx & 7;
    va[k] = *(const u32x4*)(OF + (size_t)r * 512 + h * 64 + g8 * 8);
    vb[k] = *(const u32x4*)(OB + (size_t)r * 512 + h * 64 + g8 * 8);
    vg[k] = *(const u32x4*)(P + (size_t)r * PAB + 1536 + h * 64 + g8 * 8);
  }
  const float* g = p.gdn_norm_g + li * 64 + (tid & 7) * 8;
#pragma unroll
  for (int k = 0; k < 4; ++k) {
    const int idx = (t * 4 + k) * 256 + tid;
    const int r = idx >> 6, h = (idx >> 3) & 7, g8 = idx & 7;
    float a[8], bb[8], gt[8], o[8];
    unpack8(va[k], a); unpack8(vb[k], bb); unpack8(vg[k], gt);
    float ss = 0.f;
#pragma unroll
    for (int j = 0; j < 8; ++j) { a[j] += bb[j]; ss += a[j] * a[j]; }
    ss += __shfl_xor(ss, 1); ss += __shfl_xor(ss, 2); ss += __shfl_xor(ss, 4);
    float rs = rsqrtf(ss * (1.f / 64.f) + EPS);
#pragma unroll
    for (int j = 0; j < 8; ++j) o[j] = a[j] * rs * g[j] * silu_fast(gt[j]);
    *(u32x4*)(Aout + (size_t)r * D + h * 64 + g8 * 8) = pack8(o);
  }
}

__device__ __forceinline__ void hyena_task(const Params& p, int i, int c, int v, char* smem, int dump = 0) {
  const int n = v ? CTX : SEQ, rbase = v ? TX : 0, FL = 2 * n + 16;
  const int tid = otid(), lane = tid & 63, wid = tid >> 6, l15 = lane & 15, quad = lane >> 4;
  u16* Re = (u16*)smem;
  u16* Ro = Re + (2 * SEQ + 32);
  u16* UT = (u16*)(p.ws + OFF_UT);
  u16* YT = (u16*)(p.ws + OFF_O);
  const float* rn = (const float*)(p.ws + OFF_RN) + v * 1024;
  const float* bias = p.hy_bias + (size_t)i * 1024;
  for (int o = 0; o < 2; ++o) {
    const u16* R = (const u16*)(p.ws + (v ? OFF_FZ : OFF_FX)) + ((size_t)o * 512 + c) * FL;
    __syncthreads();
    __builtin_amdgcn_fence(__ATOMIC_ACQUIRE, "workgroup");
    for (int k = tid; k < FL / 8; k += 256) ((u32x4*)Re)[k] = ((const u32x4*)R)[k];
    __syncthreads();
    for (int k = tid; k < FL - 1; k += 256) Ro[k] = Re[k + 1];
    __syncthreads();
    const u16* src = (o == 0 ? UT + (size_t)c * TT : YT + (size_t)c * TT) + rbase;
    const u16* gate = UT + (size_t)((o + 1) * 512 + c) * TT + rbase;
    u16* dst = (o == 0 ? YT + (size_t)c * TT : (dump ? YT + (size_t)(512 + c) * TT : UT + (size_t)c * TT)) + rbase;
    const float bo = bias[o * 512 + c], rno = rn[o * 512 + c];
    const int nss = n / 32;
    for (int ps = wid; ps < n / 256; ps += 4) {
      const int tbase = ps * 256;
      f32x4 acc[16];
      u32x4 afr[16];
#pragma unroll
      for (int f = 0; f < 16; ++f) acc[f] = f32x4{0.f, 0.f, 0.f, 0.f};
      const u16* cp = ((l15 & 1) ? Ro : Re) + (n - tbase - l15 + 8 * quad - (l15 & 1));
#define LDA(f) ({ const uint32_t* q_ = (const uint32_t*)(cp - 16 * (f)); mk4(q_[0], q_[1], q_[2], q_[3]); })
#pragma unroll
      for (int f = 0; f < 16; ++f) afr[f] = LDA(f);
      const u16* bp = src + (size_t)l15 * n + 8 * quad;
      u32x4 bq[8];
#pragma unroll
      for (int k = 0; k < 8; ++k) bq[k] = *(const u32x4*)(bp + 32 * k);
      for (int ss8 = 0; ss8 < nss; ss8 += 8) {
#pragma unroll
        for (int u = 0; u < 8; ++u) {
          const int ss = ss8 + u;
          if (u > 0 || ss8 > 0) {
            afr[(16 - 2 * u) & 15] = LDA(-2 * ss);
            afr[(17 - 2 * u) & 15] = LDA(-2 * ss + 1);
          }
          bf16x8 bb = as_bf8(bq[u]);
          if (ss + 8 < nss) bq[u] = *(const u32x4*)(bp + 32 * (ss + 8));
#pragma unroll
          for (int tt = 0; tt < 16; ++tt) acc[tt] = MFMA(as_bf8(afr[(tt - 2 * u) & 15]), bb, acc[tt]);
        }
      }
#undef LDA
#pragma unroll
      for (int tt = 0; tt < 16; ++tt) {
        const size_t off = (size_t)l15 * n + tbase + 16 * tt + 4 * quad;
        u32x2 sv = *(const u32x2*)(src + off), gv = *(const u32x2*)(gate + off);
        u32x2 ov;
        ov.x = pack2(lo2f(gv.x) * (acc[tt][0] * rno + lo2f(sv.x) * bo), hi2f(gv.x) * (acc[tt][1] * rno + hi2f(sv.x) * bo));
        ov.y = pack2(lo2f(gv.y) * (acc[tt][2] * rno + lo2f(sv.y) * bo), hi2f(gv.y) * (acc[tt][3] * rno + hi2f(sv.y) * bo));
        *(u32x2*)(dst + off) = ov;
      }
    }
    __builtin_amdgcn_fence(__ATOMIC_RELEASE, "workgroup");
  }
  __syncthreads();
}

#define XB_TMO      128
#define XB_XCNT(j)  (256  + 64 * (j))
#define XB_XSUB(j)  (1280 + 64 * (j))
#define XB_XGEN(j)  (2304 + 64 * (j))
#define XB_TOP      3328
#define XB_TOPGEN   3392
#define XCD_BAR_WORDS 3456
#define XB_SPIN_CAP (1u << 18)
#define LAS __attribute__((address_space(3)))

__device__ __forceinline__ unsigned xb_ld(unsigned* p)              { return __hip_atomic_load(p, __ATOMIC_RELAXED, __HIP_MEMORY_SCOPE_AGENT); }
__device__ __forceinline__ unsigned xb_add(unsigned* p, unsigned v) { return __hip_atomic_fetch_add(p, v, __ATOMIC_RELAXED, __HIP_MEMORY_SCOPE_AGENT); }
__device__ __forceinline__ unsigned xb_xcc_id() { return (unsigned)__builtin_amdgcn_s_getreg((3 << 11) | 20) & 0xFu; }
#define XB_SPIN(cond, bar) do { unsigned _sp = 0; while (cond) { __builtin_amdgcn_s_sleep(1); \
    if ((++_sp & 255u) == 0u) { if (xb_ld(&(bar)[XB_TMO])) break; if (_sp > XB_SPIN_CAP) { atomicAdd(&(bar)[XB_TMO], 1u); break; } } } } while (0)

struct XcdBarrier {
    unsigned* bar; unsigned x;
    volatile LAS unsigned* st;
};

__device__ __forceinline__ XcdBarrier xcd_barrier_post(unsigned* bar, volatile LAS unsigned* st) {
    XcdBarrier b; b.bar = bar; b.x = xb_xcc_id(); b.st = st;
    if (threadIdx.x == 0) (void)xb_add(&bar[XB_XCNT(b.x)], 1u);
    return b;
}
__device__ __forceinline__ void xcd_barrier_complete(unsigned* bar, unsigned x, unsigned& nloc, unsigned& nx) {
    const unsigned G = gridDim.x * gridDim.y * gridDim.z;
    unsigned sum, cnt, mine, sp = 0u;
    for (;;) {
        sum = 0u; cnt = 0u; mine = 0u;
#pragma unroll
        for (unsigned j = 0; j < 16; ++j) { const unsigned c = xb_ld(&bar[XB_XCNT(j)]); sum += c; cnt += (c > 0u) ? 1u : 0u; mine = (j == x) ? c : mine; }
        if (sum == G) break;
        __builtin_amdgcn_s_sleep(1);
        if ((++sp & 255u) == 0u) { if (xb_ld(&bar[XB_TMO])) break; if (sp > XB_SPIN_CAP) { atomicAdd(&bar[XB_TMO], 1u); break; } }
    }
    nloc = mine > 0u ? mine : 1u; nx = cnt > 0u ? cnt : 1u;
}

__device__ __forceinline__ void xcd_barrier(const XcdBarrier& b) {
    asm volatile("s_waitcnt vmcnt(0)" ::: "memory");
    __syncthreads();
    if (threadIdx.x == 0) {
        unsigned* bar = b.bar;
        __builtin_amdgcn_s_waitcnt(0);
        unsigned nloc = b.st[0], nx = b.st[1];
        if (nloc == 0u) { xcd_barrier_complete(bar, b.x, nloc, nx); b.st[0] = nloc; b.st[1] = nx; }
        const unsigned old = xb_add(&bar[XB_XSUB(b.x)], 1u);
        const unsigned gen = old / nloc;
        if (old + 1u == (gen + 1u) * nloc) {
            __builtin_amdgcn_fence(__ATOMIC_RELEASE, "agent");
            asm volatile("s_waitcnt vmcnt(0)" ::: "memory");
            const unsigned og = xb_add(&bar[XB_TOP], 1u);
            const unsigned tg = og / nx;
            if (og + 1u == (tg + 1u) * nx) xb_add(&bar[XB_TOPGEN], 1u);
            else XB_SPIN(xb_ld(&bar[XB_TOPGEN]) == tg, bar);
            __builtin_amdgcn_fence(__ATOMIC_ACQUIRE, "agent");
            xb_add(&bar[XB_XGEN(b.x)], 1u);
            asm volatile("s_waitcnt vmcnt(0)" ::: "memory");
        } else {
            XB_SPIN(xb_ld(&bar[XB_XGEN(b.x)]) == gen, bar);
            __builtin_amdgcn_fence(__ATOMIC_ACQUIRE, "agent");
            asm volatile("s_waitcnt vmcnt(0)" ::: "memory");
        }
    }
    __syncthreads();
}


constexpr int NPHASES = 2 + 10 + 10 + 10 + 10;

__device__ __forceinline__ int grab(int* cnt, int* s_task) {
  __syncthreads();
  if (threadIdx.x == 0) *s_task = atomicAdd(cnt, 1);
  __syncthreads();
  return *s_task;
}

__global__ void __launch_bounds__(256, 2) __attribute__((amdgpu_waves_per_eu(2, 2))) mega(Params p) {
  extern __shared__ __attribute__((aligned(16))) char smem[];
  __shared__ uint4 sh_words;
  if (threadIdx.x == 0) sh_words = make_uint4(0u, 0u, 0u, 0u);
  __syncthreads();
  int& s_task = *(int*)&sh_words.z;
  XcdBarrier xb = xcd_barrier_post((unsigned*)(p.ws + OFF_XBAR), (volatile LAS unsigned*)&sh_words);
  cg::grid_group grid = cg::this_grid();
  const int G = gridDim.x, B = blockIdx.x;
  int ph = 0;
#define RUN (ph >= p.ph_lo && ph < p.ph_hi)
#define NEXT do { ++ph; if (ph > p.ph_lo && ph < p.ph_hi) { if (ph == 1) grid.sync(); else xcd_barrier(xb); } } while (0)
  u16* H = (u16*)(p.ws + OFF_HA);
  u16* O = (u16*)(p.ws + OFF_O);
  u16* BIG = (u16*)(p.ws + OFF_BIG);
  int* cnt = (int*)(p.ws + OFF_CNT);

  if (RUN) {
    const int n_cvt = cvt_layer_tasks(p, 0, -1, smem);
    const int total = 384 + 256 + 1 + 68 + n_cvt;
    for (int rep = 0; rep < PREP; ++rep)
    for (int t = B; t < total; t += G) {
      int u = t;
      if (u < 384) { mods_task(p, u, smem); continue; }
      u -= 384;
      if (u < 256) { rope_table_task(p, u); continue; }
      u -= 256;
      if (u < 1) { lam_task(p); continue; }
      u -= 1;
      if (u < 68) { if (u < 32) h2_task(p, 0, u, smem); else if (u < 64) h2_task(p, 1, u - 32, smem); else h2_task(p, 2, u - 64, smem); continue; }
      u -= 68;
      cvt_layer_tasks(p, 0, u, smem);
    }
  }
  NEXT;
  if (RUN) row_phase(p, 0, 0, TT);
  NEXT;

  for (int l = 0; l < 4; ++l) {
    const bool last = (l == 3);
    const int li = l >> 1;
    const int Nin = (l & 1) ? PCD : PAB;
    if (RUN) gemm_phase(H, D, (const u16*)(p.ws + OFF_WIN), D, BIG, Nin, TT, Nin, D, smem);
    NEXT;
    if (RUN) {
      if (!(l & 1)) {
        const int n_rope = TX * 16 * 4 / 1024, n_vt = 16 * 4 * 2 * 18, n_halo = TT / 64;
        for (int rep = 0; rep < PREP; ++rep)
        for (int t = B; t < n_rope + n_vt + n_halo; t += G) {
          if (t < n_rope) { if (rep == 0) rope_task(p, BIG, PAB, 2080, 16, t); }
          else if (t >= n_rope + n_vt) halo_task(p, t - n_rope - n_vt);
          else {
            int u = t - n_rope;
            int kt = 2 * (u % 18), eh = (u / 18) & 1, h = (u / 36) & 3, b = u / 144;
            int row = kt < 32 ? b * SEQ + kt * 64 : TX + b * CTX + (kt - 32) * 64;
            tr128(BIG + (size_t)row * PAB + 3104 + h * 128 + eh * 64, PAB,
                 (u16*)(p.ws + OFF_VTD) + (size_t)((b * 4 + h) * 128 + eh * 64) * NKEY + kt * 64, NKEY, smem);
          }
        }
      } else {
        const int n_rope = TX * 10 * 4 / 1024, n_vt = 16 * 2 * 18, nrt = last ? TX / 64 : TT / 64, n_ut = (nrt / 2) * 24;
        for (int rep = 0; rep < PREP; ++rep)
        for (int t = B; t < n_rope + n_vt + n_ut; t += G) {
          if (t < n_rope) { if (rep == 0) rope_task(p, BIG, PCD, 0, 10, t); }
          else if (t < n_rope + n_vt) {
            int u = t - n_rope;
            int kt = 2 * (u % 18), kv = (u / 18) & 1, b = u / 36;
            int row = kt < 32 ? b * SEQ + kt * 64 : TX + b * CTX + (kt - 32) * 64;
            tr128(BIG + (size_t)row * PCD + 640 + kv * 64, PCD,
                 (u16*)(p.ws + OFF_VTS) + (size_t)((b * 2 + kv) * 64) * NKEY + kt * 64, NKEY, smem);
          } else {
            int u = t - n_rope - n_vt;
            ut_task(p, li, u / 24, u % 24, smem);
          }
        }
      }
    }
    NEXT;
    if (RUN) {
      if (!(l & 1)) for (int t = B; t < TT / 64 * 8; t += G) qkvconv_task(p, li, t);
    }
    NEXT;
    if (RUN) {
      if (!(l & 1)) {
        const int n_filt = (l == 0) ? 128 : 64;
        const int total = 256 + 1152 + n_filt;
#ifdef PROBE_MIX
        for (;;) {
          int t = grab(cnt + ph + 200, &s_task);
          if (PROBE_MIX == 1) { if (t >= 1152) break; diff_task(p, li, t, smem); }
          else { if (t >= 256) break; gdn_chain(p, li, t, smem); }
        }
        xcd_barrier(xb);
#endif
        for (;;) {
          int t = grab(cnt + ph, &s_task);
          if (t >= total) break;
          if (t < 256) gdn_chain(p, li, t, smem);
          else if (t < 1280) { const int u = t - 256; diff_task(p, li, (u >> 6) * 72 + ((u >> 4) & 3) * 18 + (u & 15), smem); }
          else if (t < 1280 + n_filt) { const int u = t - 1280; filt_task(p, (l + 1) >> 1, u >> 6, (u >> 5) & 1, u & 31, smem); }
          else { const int u = t - 1280 - n_filt; diff_task(p, li, (u >> 3) * 72 + ((u >> 1) & 3) * 18 + 16 + (u & 1), smem); }
        }
      } else {
        const int n_hy = last ? 512 : 1024, n_swa = last ? 2048 : 2304;
#ifdef PROBE_HY
        for (;;) {
          int t = grab(cnt + ph + 200, &s_task);
          if (PROBE_HY == 1) { if (t >= n_hy) break; hyena_task(p, li, t & 511, t >> 9, smem, 1); }
          else {
            if (t >= n_swa) break;
            int u = t;
            if (last) { int qb = u & 15, hq = (u >> 4) & 7, b = u >> 7; u = b * 144 + hq * 18 + qb; }
            swa_task(p, li, u, smem);
          }
        }
        xcd_barrier(xb);
#endif
        for (;;) {
          int t = grab(cnt + ph, &s_task);
          if (t >= n_hy + n_swa) break;
#ifndef NO_HY
          if (t < n_hy) hyena_task(p, li, t & 511, t >> 9, smem);
          else
#endif
          {
            int u = t - n_hy;
            if (last) { int qb = u & 15, hq = (u >> 4) & 7, b = u >> 7; u = b * 144 + hq * 18 + qb; }
#ifndef NO_SWA
            swa_task(p, li, u, smem);
#endif
          }
        }
      }
    }
    NEXT;
    if (RUN) {
      if (!(l & 1)) {
        for (int rep = 0; rep < PREP; ++rep)
        for (int t = B; t < TT * 64 / 1024; t += G) gdn_out_task(p, li, t);
      } else {
        const int nrt = last ? TX / 64 : TT / 64;
        for (int rep = 0; rep < PREP; ++rep)
        for (int t = B; t < nrt * 4; t += G) {
          int rt = t >> 2, ct = 2 * (t & 3);
          tr128((const u16*)(p.ws + OFF_UT) + (size_t)(ct * 64) * TT + rt * 64, TT, H + (size_t)(rt * 64) * D + 512 + ct * 64, D, smem);
        }
      }
    }
    NEXT;
    if (RUN) gemm_phase(H, D, (const u16*)(p.ws + OFF_WOUT), D, O, D, last ? TX : TT, D, D, smem);
    NEXT;
    if (RUN) row_phase(p, 1, l, last ? TX : TT);
    NEXT;
    const int nc_in = 16 * (((((l + 1) & 1) ? PCD : PAB) + 63) / 64), nc_io = nc_in + 256, nc_up = 1408;
    if (RUN) {
      ffn_up_phase(p, l, last ? 130 : 147, smem);
      if (!last) for (;;) { const int t = grab(cnt + ph, &s_task); if (t >= nc_io) break; cvt_layer_tasks(p, l + 1, t, smem); }
    }
    NEXT;
    if (RUN) {
      gemm_phase((const u16*)(p.ws + OFF_ACT), DFF, (const u16*)(p.ws + OFF_WDN), DFF, O, D, last ? TX : TT, D, DFF, smem);
      if (!last) for (;;) { const int t = grab(cnt + ph, &s_task); if (t >= nc_up) break; cvt_layer_tasks(p, l + 1, nc_io + t, smem); }
    }
    NEXT;
    if (RUN) {
      row_phase(p, 2, l, last ? TX : TT);
      if (!last) {
        const int n_cvt = cvt_layer_tasks(p, l + 1, -1, smem);
        const int n_f = 0;
        for (int t = nc_io + nc_up + B; t < n_cvt + n_f; t += G) {
          if (t < n_cvt) cvt_layer_tasks(p, l + 1, t, smem);
          else {
            int u = t - n_cvt;
            filt_task(p, (l + 1) >> 1, u >> 6, (u >> 5) & 1, u & 31, smem);
          }
        }
      }
    }
    NEXT;
  }
#undef RUN
#undef NEXT
}

extern "C" void kernel_launch(void* const* d_in, const int* in_sizes, int n_in, void* d_out, int out_size, void* d_ws,
                              size_t ws_size, hipStream_t stream) {
  static int grid = 0;
  if (grid == 0) {
    if (n_in != 29 || ws_size < OFF_HALO + (size_t)576 * 2 * 1536 * 2) { fprintf(stderr, "kernel_launch: unexpected n_in %d / ws %zu (need %zu)\n", n_in, ws_size, (size_t)WS_END); grid = -1; return; }
    int dev = 0, cus = 0, per_cu = 0;
    hipGetDevice(&dev);
    hipDeviceGetAttribute(&cus, hipDeviceAttributeMultiprocessorCount, dev);
    if (hipFuncSetAttribute((const void*)mega, hipFuncAttributeMaxDynamicSharedMemorySize, LDS_BYTES) != hipSuccess) { fprintf(stderr, "hipFuncSetAttribute failed\n"); grid = -1; return; }
    hipOccupancyMaxActiveBlocksPerMultiprocessor(&per_cu, (const void*)mega, 256, LDS_BYTES);
    if (per_cu < 1) { fprintf(stderr, "occupancy query returned %d\n", per_cu); per_cu = 1; }
    if (per_cu > 2) per_cu = 2;
    grid = cus * per_cu;
    fprintf(stderr, "kernel_launch: grid %d (%d CUs x %d)\n", grid, cus, per_cu);
  }
  if (grid < 0) return;
  hipMemsetAsync((char*)d_ws + OFF_CNT, 0, 4096, stream);
  hipMemsetAsync((char*)d_ws + OFF_XBAR, 0, 16384, stream);
  Params p{};
  const float** pp = (const float**)&p;
  for (int i = 0; i < 29; ++i) pp[i] = (const float*)d_in[i];
  p.out = (float*)d_out;
  p.ws = (char*)d_ws;
#if MULTI_LAUNCH
  for (int k = 0; k < NPHASES; ++k) {
    p.ph_lo = k; p.ph_hi = k + 1;
    hipLaunchKernelGGL(mega, dim3(grid), dim3(256), LDS_BYTES, stream, p);
  }
#else
  p.ph_lo = 0; p.ph_hi = NPHASES;
  void* args[] = {&p};
  hipError_t e = hipLaunchCooperativeKernel((const void*)mega, dim3(grid), dim3(256), args, LDS_BYTES, stream);
  if (e != hipSuccess) fprintf(stderr, "cooperative launch failed: %s (grid %d)\n", hipGetErrorString(e), grid);
#endif
}
```
